# Optimizing an MI355X kernel written in HIP

```python
import math
import jax, jax.numpy as jnp
from jax import lax
import numpy as np

D_MODEL = 1024
BATCH = 4
SEQ = 4096
DEPTH = 2

PLE_DIM = 256
N_EVEN = (DEPTH + 1) // 2
N_ODD = DEPTH // 2
DEEPNORM_ALPHA = (2.0 * DEPTH) ** 0.25
DEEPNORM_BETA = (8.0 * DEPTH) ** -0.25
LN_EPS = 1e-5
A_WIDTH = D_MODEL // 2
A_GROUPS = 8
A_GROUP_DIM = A_WIDTH // A_GROUPS
A_CHUNK = 128
B_HEADS = 4
B_DV = (D_MODEL // 2) // B_HEADS
B_DK = B_DV // 2
B_GATE_RANK = 16
B_TAU = 16.0
B_CHUNK = 64
C_HEADS = 8
C_DH = D_MODEL // (2 * C_HEADS)
C_QBLOCK = 128
FFN_DIM = 2816
N_EXPERTS = 8
TOP_K = 2
EXPERT_DIM = 3584
MOE_BLOCK = 256
E_SPLIT_SIZES = [A_WIDTH, A_WIDTH, B_HEADS * B_DK, B_HEADS * B_DK, B_HEADS * B_DV, B_HEADS * B_DV]
E_IN_COLS = sum(E_SPLIT_SIZES) + B_GATE_RANK
E_MIX_WIDTH = A_WIDTH + B_HEADS * B_DV

kernel_name = "hybrid_gmlp_gla_diffattn_moe_deepnorm"

F32 = jnp.float32


def layer_norm(x, g, b):
    xf = x.astype(F32)
    mu = jnp.mean(xf, axis=-1, keepdims=True)
    var = jnp.mean(jnp.square(xf - mu), axis=-1, keepdims=True)
    return ((xf - mu) * lax.rsqrt(var + LN_EPS) * g + b).astype(x.dtype)


def rms_norm(x, g):
    xf = x.astype(F32)
    return (xf * lax.rsqrt(jnp.mean(jnp.square(xf), axis=-1, keepdims=True) + LN_EPS) * g).astype(x.dtype)


def spatial_gating(u, v, ln_g, ln_b, ws, bs):
    bn, s, _ = v.shape
    nc = s // A_CHUNK
    v = layer_norm(v, ln_g, ln_b).reshape(bn, nc, A_CHUNK, A_GROUPS, A_GROUP_DIM)
    causal = jnp.tril(jnp.ones((A_CHUNK, A_CHUNK), dtype=bool))
    w = jnp.where(causal, ws, 0)
    sg = jnp.einsum('gts,bcsgd->bctgd', w, v) + bs.T[:, :, None]
    return u * sg.reshape(bn, s, A_WIDTH)


def gla_chunked(q, k, v, log_a):
    bn, s, h, dk = q.shape
    dv = v.shape[-1]
    L = B_CHUNK
    nc = s // L
    q, k, v, log_a = [t.reshape(bn, nc, L, h, t.shape[-1]) for t in (q, k, v, log_a)]
    b = jnp.cumsum(log_a, axis=2)
    ref = b[:, :, L // 2 - 1:L // 2]
    b_last = b[:, :, L - 1:L]
    causal = jnp.tril(jnp.ones((L, L), dtype=bool))
    scores = jnp.einsum('bclhk,bcmhk->bchlm', q * jnp.exp(b - ref), k * jnp.exp(ref - b))
    scores = jnp.where(causal, scores, 0.0)
    o_intra = jnp.einsum('bchlm,bcmhv->bclhv', scores, v)
    kv = jnp.einsum('bclhk,bclhv->bchkv', k * jnp.exp(b_last - b), v)
    decay = jnp.exp(b_last[:, :, 0])

    def step(state, inp):
        d, kv_c = inp
        return d[..., None] * state + kv_c, state

    init = jnp.zeros((bn, h, dk, dv), F32)
    _, s_prev = lax.scan(step, init, (jnp.moveaxis(decay, 1, 0), jnp.moveaxis(kv, 1, 0)))
    s_prev = jnp.moveaxis(s_prev, 0, 1)
    o_inter = jnp.einsum('bclhk,bchkv->bclhv', q * jnp.exp(b), s_prev)
    return (o_intra + o_inter).reshape(bn, s, h, dv)


def even_mixer(x, w_in, a_ln_g, a_ln_b, a_ws, a_bs, b_w_gate_up, b_b_gate, b_norm_g, w_out):
    bn, s, _ = x.shape
    z = x @ w_in
    splits = np.cumsum(E_SPLIT_SIZES).tolist()
    u, v, q, k, vb, r, g_low = jnp.split(z, splits, axis=-1)
    ya = spatial_gating(jax.nn.gelu(u), jax.nn.gelu(v), a_ln_g, a_ln_b, a_ws, a_bs)
    q = q.reshape(bn, s, B_HEADS, B_DK).astype(F32) * (B_DK ** -0.5)
    k = k.reshape(bn, s, B_HEADS, B_DK).astype(F32)
    vb = vb.reshape(bn, s, B_HEADS, B_DV).astype(F32)
    log_a = jax.nn.log_sigmoid((g_low @ b_w_gate_up + b_b_gate).astype(F32)) / B_TAU
    log_a = log_a.reshape(bn, s, B_HEADS, B_DK)
    o = rms_norm(gla_chunked(q, k, vb, log_a), b_norm_g)
    yb = o.reshape(bn, s, B_HEADS * B_DV).astype(x.dtype) * jax.nn.silu(r)
    return jnp.concatenate([ya, yb], axis=-1) @ w_out


def diff_attention(x, w_qkv, lam_q1, lam_k1, lam_q2, lam_k2, subln_g, w_out, lambda_init):
    bn, s, _ = x.shape
    q, k, v = jnp.split(x @ w_qkv, 3, axis=-1)
    q = q.reshape(bn, s, C_HEADS, 2, C_DH) * (C_DH ** -0.5)
    k = k.reshape(bn, s, C_HEADS, 2, C_DH)
    v = v.reshape(bn, s, C_HEADS, 2 * C_DH)
    lam = (jnp.exp(jnp.sum(lam_q1 * lam_k1).astype(F32))
           - jnp.exp(jnp.sum(lam_q2 * lam_k2).astype(F32)) + lambda_init)
    nb = s // C_QBLOCK
    qb = jnp.moveaxis(q.reshape(bn, nb, C_QBLOCK, C_HEADS, 2, C_DH), 1, 0)
    kpos = jnp.arange(s)

    def block(args):
        qi, i = args
        sc = jnp.einsum('bqhcd,bkhcd->bhcqk', qi, k).astype(F32)
        qpos = i * C_QBLOCK + jnp.arange(C_QBLOCK)
        sc = jnp.where(kpos[None, :] <= qpos[:, None], sc, -jnp.inf)
        pr = jax.nn.softmax(sc, axis=-1)
        a = pr[:, :, 0] - lam * pr[:, :, 1]
        return jnp.einsum('bhqk,bkhe->bqhe', a.astype(v.dtype), v)

    o = lax.map(block, (qb, jnp.arange(nb)))
    o = jnp.moveaxis(o, 0, 1).reshape(bn, s, C_HEADS, 2 * C_DH)
    o = rms_norm(o, subln_g) * (1.0 - lambda_init)
    return o.reshape(bn, s, C_HEADS * 2 * C_DH) @ w_out


def swiglu(x, wg, wu, wd):
    return (jax.nn.silu(x @ wg) * (x @ wu)) @ wd


def moe_swiglu(x, w_router, wg, wu, wd):
    bn, s, d = x.shape
    n = bn * s
    xf = x.reshape(n, d)
    logits = (xf @ w_router).astype(F32)
    top_val, top_idx = lax.top_k(logits, TOP_K)
    gates = jax.nn.softmax(top_val, axis=-1)
    flat_e = top_idx.reshape(-1)
    flat_tok = jnp.repeat(jnp.arange(n, dtype=jnp.int32), TOP_K)
    flat_g = gates.reshape(-1)
    order = jnp.argsort(flat_e)
    se = flat_e[order]
    counts = jnp.bincount(flat_e, length=N_EXPERTS)
    padded = (counts + MOE_BLOCK - 1) // MOE_BLOCK * MOE_BLOCK
    start = jnp.cumsum(counts) - counts
    pend = jnp.cumsum(padded)
    pstart = pend - padded
    dest = pstart[se] + jnp.arange(n * TOP_K) - start[se]
    n_rows = n * TOP_K + N_EXPERTS * MOE_BLOCK
    n_blocks = n_rows // MOE_BLOCK
    row_tok = jnp.full((n_rows,), n, jnp.int32).at[dest].set(flat_tok[order])
    row_gate = jnp.zeros((n_rows,), F32).at[dest].set(flat_g[order])
    blk_e = jnp.minimum(jnp.searchsorted(pend, jnp.arange(n_blocks) * MOE_BLOCK, side='right'), N_EXPERTS - 1)
    x_pad = jnp.concatenate([xf, jnp.zeros((1, d), xf.dtype)], axis=0)
    xin = x_pad[row_tok].reshape(n_blocks, MOE_BLOCK, d)

    def expert_block(args):
        xb, e = args
        return (jax.nn.silu(xb @ wg[e]) * (xb @ wu[e])) @ wd[e]

    y = lax.map(expert_block, (xin, blk_e)).reshape(n_rows, d)
    out = jnp.zeros((n + 1, d), F32).at[row_tok].add(y.astype(F32) * row_gate[:, None])[:n]
    return out.astype(x.dtype).reshape(bn, s, d)


def per_layer_embed(x, p_i, w_proj, w_gate, b_gate):
    return x + jax.nn.sigmoid(x @ w_gate + b_gate) * (p_i @ w_proj)


def setup_inputs(seed: int = 0) -> dict:
    key = jax.random.key(seed)
    keys = iter(jax.random.split(key, 64))

    def nrm(shape, scale):
        return jax.random.normal(next(keys), shape, F32) * scale

    def gain(shape):
        return 1.0 + nrm(shape, 0.02)

    D = D_MODEL
    beta = DEEPNORM_BETA
    return {
        "x": nrm((BATCH, SEQ, D), 1.0),
        "p": nrm((DEPTH, BATCH, SEQ, PLE_DIM), 1.0),
        "e_w_in": nrm((N_EVEN, D, E_IN_COLS), D ** -0.5),
        "e_a_ln_g": gain((N_EVEN, A_WIDTH)),
        "e_a_ln_b": nrm((N_EVEN, A_WIDTH), 0.02),
        "e_a_ws": nrm((N_EVEN, A_GROUPS, A_CHUNK, A_CHUNK), A_CHUNK ** -0.5),
        "e_a_bs": gain((N_EVEN, A_GROUPS, A_CHUNK)),
        "e_b_w_gate_up": nrm((N_EVEN, B_GATE_RANK, B_HEADS * B_DK), B_GATE_RANK ** -0.5),
        "e_b_b_gate": nrm((N_EVEN, B_HEADS * B_DK), 0.02),
        "e_b_norm_g": gain((N_EVEN, B_DV)),
        "e_w_out": nrm((N_EVEN, E_MIX_WIDTH, D), E_MIX_WIDTH ** -0.5 * beta),
        "e_ln1_g": gain((N_EVEN, D)),
        "e_ln1_b": nrm((N_EVEN, D), 0.02),
        "e_ffn_wg": nrm((N_EVEN, D, FFN_DIM), D ** -0.5),
        "e_ffn_wu": nrm((N_EVEN, D, FFN_DIM), D ** -0.5),
        "e_ffn_wd": nrm((N_EVEN, FFN_DIM, D), FFN_DIM ** -0.5 * beta),
        "e_ln2_g": gain((N_EVEN, D)),
        "e_ln2_b": nrm((N_EVEN, D), 0.02),
        "o_w_qkv": nrm((N_ODD, D, 3 * C_HEADS * 2 * C_DH), D ** -0.5),
        "o_lam_q1": nrm((N_ODD, C_DH), 0.1),
        "o_lam_k1": nrm((N_ODD, C_DH), 0.1),
        "o_lam_q2": nrm((N_ODD, C_DH), 0.1),
        "o_lam_k2": nrm((N_ODD, C_DH), 0.1),
        "o_subln_g": gain((N_ODD, 2 * C_DH)),
        "o_w_out": nrm((N_ODD, C_HEADS * 2 * C_DH, D), (C_HEADS * 2 * C_DH) ** -0.5 * beta),
        "o_ln1_g": gain((N_ODD, D)),
        "o_ln1_b": nrm((N_ODD, D), 0.02),
        "o_router": nrm((N_ODD, D, N_EXPERTS), D ** -0.5),
        "o_exp_wg": nrm((N_ODD, N_EXPERTS, D, EXPERT_DIM), D ** -0.5),
        "o_exp_wu": nrm((N_ODD, N_EXPERTS, D, EXPERT_DIM), D ** -0.5),
        "o_exp_wd": nrm((N_ODD, N_EXPERTS, EXPERT_DIM, D), EXPERT_DIM ** -0.5 * beta),
        "o_ln2_g": gain((N_ODD, D)),
        "o_ln2_b": nrm((N_ODD, D), 0.02),
        "ple_w_proj": nrm((DEPTH, PLE_DIM, D), PLE_DIM ** -0.5),
        "ple_w_gate": nrm((DEPTH, D, D), D ** -0.5),
        "ple_b_gate": nrm((DEPTH, D), 0.02),
    }


def reference(x, p,
              e_w_in, e_a_ln_g, e_a_ln_b, e_a_ws, e_a_bs, e_b_w_gate_up, e_b_b_gate, e_b_norm_g,
              e_w_out, e_ln1_g, e_ln1_b, e_ffn_wg, e_ffn_wu, e_ffn_wd, e_ln2_g, e_ln2_b,
              o_w_qkv, o_lam_q1, o_lam_k1, o_lam_q2, o_lam_k2, o_subln_g, o_w_out, o_ln1_g, o_ln1_b,
              o_router, o_exp_wg, o_exp_wu, o_exp_wd, o_ln2_g, o_ln2_b,
              ple_w_proj, ple_w_gate, ple_b_gate):
    for i in range(DEPTH):
        j = i // 2
        if i % 2 == 0:
            m = even_mixer(x, e_w_in[j], e_a_ln_g[j], e_a_ln_b[j], e_a_ws[j], e_a_bs[j],
                           e_b_w_gate_up[j], e_b_b_gate[j], e_b_norm_g[j], e_w_out[j])
            x = layer_norm(DEEPNORM_ALPHA * x + m, e_ln1_g[j], e_ln1_b[j])
            f = swiglu(x, e_ffn_wg[j], e_ffn_wu[j], e_ffn_wd[j])
            x = layer_norm(DEEPNORM_ALPHA * x + f, e_ln2_g[j], e_ln2_b[j])
        else:
            lambda_init = 0.8 - 0.6 * math.exp(-0.3 * i)
            m = diff_attention(x, o_w_qkv[j], o_lam_q1[j], o_lam_k1[j], o_lam_q2[j], o_lam_k2[j],
                               o_subln_g[j], o_w_out[j], lambda_init)
            x = layer_norm(DEEPNORM_ALPHA * x + m, o_ln1_g[j], o_ln1_b[j])
            f = moe_swiglu(x, o_router[j], o_exp_wg[j], o_exp_wu[j], o_exp_wd[j])
            x = layer_norm(DEEPNORM_ALPHA * x + f, o_ln2_g[j], o_ln2_b[j])
        x = per_layer_embed(x, p[i], ple_w_proj[i], ple_w_gate[i], ple_b_gate[i])
    return x
```

```cpp
#include <hip/hip_runtime.h>
#include <hip/hip_bf16.h>
#include <cstdio>
#include <cstdint>
#include <cmath>
namespace pg8 {
#define PG8_LAS __attribute__((address_space(3)))
typedef unsigned short bf16_t;
typedef short bf16x8 __attribute__((ext_vector_type(8)));
typedef float f32x4 __attribute__((ext_vector_type(4)));
typedef unsigned u32x4 __attribute__((ext_vector_type(4)));
constexpr int BM = 256, BK = 64, HALF = 128, HTB = HALF * BK * 2  , STAGE_BYTES = 8 * HTB, NXCD = 8, WGM = 8;

__host__ __device__ __forceinline__ int lds_byte(int r, int c) { const int st = (r >> 4) * 2 + (c >> 5), rr = r & 15, cc = c & 31, ob = rr * 64 + cc * 2; return st * 1024 + (ob ^ (((ob >> 9) & 1) << 5)); }
__host__ __device__ __forceinline__ void stage_rc(int b, int& R, int& C) { const int st = b / 1024, sb = b % 1024, swz = sb ^ (((sb >> 9) & 1) << 5); R = (st >> 1) * 16 + swz / 64; C = (st & 1) * 32 + (swz % 64) / 2; }
__host__ __device__ __forceinline__ int perm32(int rho) { const int n = rho >> 4, i = rho & 15; return 8 * (i >> 2) + 4 * n + (i & 3); }

struct Unit { int pm, pn, e; };
struct Gemm { const bf16_t* A; const bf16_t* Bt; int M, N, K; size_t bstride; };

struct StaticOrder {
    int nM, nN, nwg, G, c;
    __host__ __device__ void init(int M, int N, int G_, int c_) { nM = M / BM; nN = N / BM; nwg = nM * nN; G = G_; c = c_; }
    __host__ __device__ bool next(int i, Unit& u) const {
        const long L = (long)i * G + c; if (L >= nwg) return false;
        int wgid = (int)L; { const int q = nwg / NXCD, r = nwg % NXCD, xcd = wgid % NXCD, off = wgid / NXCD; wgid = (xcd < r ? xcd * (q + 1) : r * (q + 1) + (xcd - r) * q) + off; }
        const int nig = WGM * nN, gid = wgid / nig, fm = gid * WGM, gsz = (nM - fm) < WGM ? (nM - fm) : WGM;
        u.pm = fm + ((wgid % nig) % gsz); u.pn = (wgid % nig) / gsz; u.e = 0; return true;
    }
    __device__ __forceinline__ void a_ready(const Unit&) const {}
    __device__ __forceinline__ void done(const Unit&) const {}
};

__device__ __forceinline__ unsigned cvt_pk_bf16(float lo, float hi) { unsigned r; asm volatile("v_cvt_pk_bf16_f32 %0, %1, %2" : "=v"(r) : "v"(lo), "v"(hi)); return r; }
typedef float f32x2 __attribute__((ext_vector_type(2)));
__device__ __forceinline__ f32x2 gelu_pk(f32x2 v) {
    const f32x2 av = __builtin_elementwise_abs(v), d = av * 0.2316418882f + 1.0f;
    f32x2 t; t.x = __builtin_amdgcn_rcpf(d.x); t.y = __builtin_amdgcn_rcpf(d.y);
    f32x2 q = t * 0.5307027145f + (-0.7265760135f); q = q * t + 0.7107068705f; q = q * t + (-0.142248368f); q = q * t + 0.127414796f; q = q * t;
    const f32x2 s = (v * v) * (-0.72134752044f);
    f32x2 e; e.x = __builtin_amdgcn_exp2f(s.x); e.y = __builtin_amdgcn_exp2f(s.y);
    const f32x2 m = v * (q * e), r = v - m;
    f32x2 o; o.x = v.x < 0.f ? m.x : r.x; o.y = v.y < 0.f ? m.y : r.y; return o;
}

template <int ACT  > struct EpiBf16 {
    static constexpr bool PERM = true, AFTER_DRAIN = false; static_assert(ACT == 0 || ACT == 1, "EpiBf16: ACT is 0 (none) or 1 (gelu_pk)");
    bf16_t* O; int ldc; const float* bias; int split_cols; size_t split_stride; float scale0;
    __device__ __forceinline__ void operator()(const f32x4 (&acc)[2][2][4][2], const Unit& u, int wr, int wc, int fr, int fq) const {
        const int row0 = u.pm * BM + wr * 64 + fr; int colt = u.pn * BM; bf16_t* base = O;
        float sc = 1.f; if (split_cols) { const int t = colt / split_cols; base += (size_t)t * split_stride; colt -= t * split_cols; if (t == 0) sc = scale0; }
        const int col0 = colt + wc * 32 + 8 * fq, bcol0 = u.pn * BM + wc * 32 + 8 * fq;
        f32x4 bv[2][2];
#pragma unroll
        for (int bj = 0; bj < 2; ++bj)
#pragma unroll
            for (int n = 0; n < 2; ++n) bv[bj][n] = bias ? *(const f32x4*)(bias + bcol0 + bj * HALF + 4 * n) : (f32x4){0.f, 0.f, 0.f, 0.f};
#pragma unroll
        for (int ai = 0; ai < 2; ++ai)
#pragma unroll
            for (int m = 0; m < 4; ++m) { bf16_t* rowp = base + (size_t)(row0 + ai * HALF + m * 16) * ldc + col0;
#pragma unroll
                for (int bj = 0; bj < 2; ++bj) { f32x4 v0 = acc[ai][bj][m][0] + bv[bj][0], v1 = acc[ai][bj][m][1] + bv[bj][1];
                    if (ACT == 1) { f32x2 a = gelu_pk((f32x2){v0[0], v0[1]}), b = gelu_pk((f32x2){v0[2], v0[3]}), c = gelu_pk((f32x2){v1[0], v1[1]}), d = gelu_pk((f32x2){v1[2], v1[3]});
                        v0 = (f32x4){a.x, a.y, b.x, b.y}; v1 = (f32x4){c.x, c.y, d.x, d.y}; }
                    v0 = v0 * sc; v1 = v1 * sc; u32x4 w; w.x = cvt_pk_bf16(v0[0], v0[1]); w.y = cvt_pk_bf16(v0[2], v0[3]); w.z = cvt_pk_bf16(v1[0], v1[1]); w.w = cvt_pk_bf16(v1[2], v1[3]);
                    *(u32x4*)(rowp + bj * HALF) = w; } }
    }
};
__device__ __forceinline__ float fast_sigmoid(float x) { return __builtin_amdgcn_rcpf(1.0f + __builtin_amdgcn_exp2f(-1.4426950408889634f * x)); }
__device__ __forceinline__ float gelu_tanh(float x) { const float u = 1.5957691216057308f * (x + 0.044715f * x * x * x); return x * fast_sigmoid(u); }
__device__ __forceinline__ float silu_f(float x) { return x * fast_sigmoid(x); }
struct EpiZ {
    static constexpr bool PERM = true, AFTER_DRAIN = false;
    bf16_t* O; int ldc;
    __device__ __forceinline__ void operator()(const f32x4 (&acc)[2][2][4][2], const Unit& u, int wr, int wc, int fr, int fq) const {
        const int row0 = u.pm * BM + wr * 64 + fr, col0 = u.pn * BM + wc * 32 + 8 * fq;
        const int mode = u.pn < 4 ? 1 : (u.pn == 4 ? 2 : 0);
#pragma unroll
        for (int ai = 0; ai < 2; ++ai)
#pragma unroll
            for (int m = 0; m < 4; ++m) { bf16_t* rowp = O + (size_t)(row0 + ai * HALF + m * 16) * ldc + col0;
#pragma unroll
                for (int bj = 0; bj < 2; ++bj) { f32x4 v0 = acc[ai][bj][m][0], v1 = acc[ai][bj][m][1];
                    if (mode == 1) {
#pragma unroll
                        for (int i = 0; i < 4; ++i) { v0[i] = gelu_tanh(v0[i]); v1[i] = gelu_tanh(v1[i]); } }
                    else if (mode == 2) { v0 = v0 * 0.125f; v1 = v1 * 0.125f; }
                    u32x4 w; w.x = cvt_pk_bf16(v0[0], v0[1]); w.y = cvt_pk_bf16(v0[2], v0[3]); w.z = cvt_pk_bf16(v1[0], v1[1]); w.w = cvt_pk_bf16(v1[2], v1[3]);
                    *(u32x4*)(rowp + bj * HALF) = w; } }
    }
};
struct EpiGU {
    static constexpr bool PERM = true, AFTER_DRAIN = false;
    bf16_t* O; int ldc;
    __device__ __forceinline__ void operator()(const f32x4 (&acc)[2][2][4][2], const Unit& u, int wr, int wc, int fr, int fq) const {
        const int row0 = u.pm * BM + wr * 64 + fr, col0 = u.pn * HALF + wc * 32 + 8 * fq;
#pragma unroll
        for (int ai = 0; ai < 2; ++ai)
#pragma unroll
            for (int m = 0; m < 4; ++m) { bf16_t* rowp = O + (size_t)(row0 + ai * HALF + m * 16) * ldc + col0;
                f32x4 h0, h1;
#pragma unroll
                for (int i = 0; i < 4; ++i) { h0[i] = silu_f(acc[ai][0][m][0][i]) * acc[ai][1][m][0][i]; h1[i] = silu_f(acc[ai][0][m][1][i]) * acc[ai][1][m][1][i]; }
                u32x4 w; w.x = cvt_pk_bf16(h0[0], h0[1]); w.y = cvt_pk_bf16(h0[2], h0[3]); w.z = cvt_pk_bf16(h1[0], h1[1]); w.w = cvt_pk_bf16(h1[2], h1[3]);
                *(u32x4*)rowp = w; }
    }
};
struct EpiRes {
    static constexpr bool PERM = false, AFTER_DRAIN = false;
    const float* res; float* out; int ldc; float alpha;
    __device__ __forceinline__ void operator()(const f32x4 (&acc)[2][2][4][2], const Unit& u, int wr, int wc, int fr, int fq) const {
        const int col0 = u.pn * BM + wc * 32 + 4 * fq;
#pragma unroll
        for (int ai = 0; ai < 2; ++ai)
#pragma unroll
            for (int m = 0; m < 4; ++m) { const size_t off = (size_t)(u.pm * BM + ai * HALF + wr * 64 + m * 16 + fr) * ldc + col0;
#pragma unroll
                for (int bj = 0; bj < 2; ++bj)
#pragma unroll
                    for (int n = 0; n < 2; ++n) { const f32x4 r = *(const f32x4*)(res + off + bj * HALF + n * 16); *(f32x4*)(out + off + bj * HALF + n * 16) = r * alpha + acc[ai][bj][m][n]; } }
    }
};
struct EpiPle {
    static constexpr bool PERM = false, AFTER_DRAIN = false;
    const float* x; float* out; const bf16_t* pp; bf16_t* xb; const float* bias; int ldc;
    __device__ __forceinline__ void operator()(const f32x4 (&acc)[2][2][4][2], const Unit& u, int wr, int wc, int fr, int fq) const {
        typedef unsigned u32x2v __attribute__((ext_vector_type(2)));
        const int col0 = u.pn * BM + wc * 32 + 4 * fq;
        f32x4 bv[2][2];
#pragma unroll
        for (int bj = 0; bj < 2; ++bj)
#pragma unroll
            for (int n = 0; n < 2; ++n) bv[bj][n] = *(const f32x4*)(bias + col0 + bj * HALF + n * 16);
#pragma unroll
        for (int ai = 0; ai < 2; ++ai)
#pragma unroll
            for (int m = 0; m < 4; ++m) { const size_t off = (size_t)(u.pm * BM + ai * HALF + wr * 64 + m * 16 + fr) * ldc + col0;
#pragma unroll
                for (int bj = 0; bj < 2; ++bj)
#pragma unroll
                    for (int n = 0; n < 2; ++n) { const size_t o2 = off + bj * HALF + n * 16;
                        const f32x4 xv = *(const f32x4*)(x + o2); const u32x2v pw = *(const u32x2v*)(pp + o2); const f32x4 a = acc[ai][bj][m][n] + bv[bj][n];
                        f32x4 pv; pv[0] = __uint_as_float(pw.x << 16); pv[1] = __uint_as_float(pw.x & 0xffff0000u); pv[2] = __uint_as_float(pw.y << 16); pv[3] = __uint_as_float(pw.y & 0xffff0000u);
                        f32x4 o;
#pragma unroll
                        for (int i = 0; i < 4; ++i) o[i] = xv[i] + fast_sigmoid(a[i]) * pv[i];
                        *(f32x4*)(out + o2) = o;
                        if (xb) { u32x2v w; w.x = cvt_pk_bf16(o[0], o[1]); w.y = cvt_pk_bf16(o[2], o[3]); *(u32x2v*)(xb + o2) = w; } } }
    }
};
template <class Epi, class Sched, bool ALIGN_EPI = false, bool SP2 = false>
__device__ __forceinline__ void gemm_phase(PG8_LAS unsigned char* lds, const Gemm g, const Sched& S, const Epi& E) {
    int tid_ = threadIdx.x; asm volatile("" : "+v"(tid_));
    const int tid = tid_, wid = __builtin_amdgcn_readfirstlane(tid >> 6), lane = tid & 63, wr = wid >> 2, wc = wid & 3, fr = lane & 15, fq = lane >> 4;
    const int K = g.K, nt = K / BK;
    unsigned voffA[2], voffB[2];
#pragma unroll
    for (int i = 0; i < 2; ++i) { int R, C; stage_rc(tid * 16 + i * 8192, R, C); const int Rb = Epi::PERM ? ((R & ~31) + perm32(R & 31)) : R;
        voffA[i] = (unsigned)(R * K + C) * 2u; voffB[i] = (unsigned)(Rb * K + C) * 2u; }
    const size_t kstep = (size_t)(BK * 2);
    const size_t hstep = (size_t)HALF * K * 2;
    const size_t tstep = 2 * hstep;
    const unsigned ldsw = (unsigned)wid * 1024u;
    const int aoff = lds_byte(wr * 64 + fr, fq * 8), boff = lds_byte(wc * 32 + fr, fq * 8);
#define PG8_SA(b, h) (((b) * 2 + (h)) * HTB)
#define PG8_SB(b, h) ((4 + (b) * 2 + (h)) * HTB)
#define PG8_STAGE(bufoff, gbase, voff) do { _Pragma("unroll") for (int _i = 0; _i < 2; ++_i) \
        __builtin_amdgcn_global_load_lds((const unsigned*)((const char*)(gbase) + (voff)[_i]), (PG8_LAS unsigned*)(lds + (bufoff) + ldsw + _i * 8192), 16, 0, 0); } while (0)
#define PG8_LDA(dst, b, h) do { _Pragma("unroll") for (int m = 0; m < 4; ++m) _Pragma("unroll") for (int k = 0; k < 2; ++k) dst[m][k] = *(const PG8_LAS bf16x8*)(lds + PG8_SA(b, h) + aoff + m * 2048 + k * 1024); } while (0)
#define PG8_LDB(dst, b, h) do { _Pragma("unroll") for (int n = 0; n < 2; ++n) _Pragma("unroll") for (int k = 0; k < 2; ++k) dst[n][k] = *(const PG8_LAS bf16x8*)(lds + PG8_SB(b, h) + boff + n * 2048 + k * 1024); } while (0)
#define PG8_MMA(ai, bj, At, Bt) do { __builtin_amdgcn_s_setprio(1); _Pragma("unroll") for (int m = 0; m < 4; ++m) _Pragma("unroll") for (int n = 0; n < 2; ++n) _Pragma("unroll") for (int k = 0; k < 2; ++k) \
        acc[ai][bj][m][n] = __builtin_amdgcn_mfma_f32_16x16x32_bf16(Bt[n][k], At[m][k], acc[ai][bj][m][n], 0, 0, 0); __builtin_amdgcn_s_setprio(0); } while (0)
#define PG8_WAIT_V(n) asm volatile("s_waitcnt vmcnt(" #n ")" ::: "memory")
#define PG8_WAIT_L(n) asm volatile("s_waitcnt lgkmcnt(" #n ")" ::: "memory")
#define PG8_BAR __builtin_amdgcn_s_barrier()
#define PG8_SCHED __builtin_amdgcn_sched_barrier(0)
    Unit cur, nxt; int ui = 0;
    if (!S.next(0, cur)) return;
    f32x4 acc[2][2][4][2];
#pragma unroll
    for (int a = 0; a < 2; ++a)
#pragma unroll
        for (int b = 0; b < 2; ++b)
#pragma unroll
            for (int m = 0; m < 4; ++m)
#pragma unroll
                for (int n = 0; n < 2; ++n) acc[a][b][m][n] = (f32x4){0.f, 0.f, 0.f, 0.f};
    bf16x8 At[4][2], B0[2][2], B1[2][2];
    const char* cA = (const char*)g.A + (size_t)cur.pm * tstep; const char* cB = (const char*)g.Bt + (size_t)cur.e * g.bstride * 2 + (size_t)cur.pn * tstep;
    S.a_ready(cur);
    if constexpr (SP2) {
        PG8_STAGE(PG8_SB(0, 0), cB, voffB); PG8_STAGE(PG8_SB(0, 1), cB + hstep, voffB); PG8_STAGE(PG8_SA(0, 0), cA, voffA); PG8_STAGE(PG8_SA(0, 1), cA + hstep, voffA);
        if (wr == 1) PG8_BAR;
        PG8_WAIT_V(2); PG8_BAR;
        PG8_STAGE(PG8_SB(1, 0), cB + kstep, voffB); PG8_STAGE(PG8_SA(1, 0), cA + kstep, voffA); PG8_STAGE(PG8_SB(1, 1), cB + hstep + kstep, voffB);
        PG8_WAIT_V(6); PG8_BAR;
    } else {
        PG8_STAGE(PG8_SB(0, 0), cB, voffB); PG8_STAGE(PG8_SA(0, 0), cA, voffA); PG8_STAGE(PG8_SB(0, 1), cB + hstep, voffB); PG8_STAGE(PG8_SA(0, 1), cA + hstep, voffA);
        if (wr == 1) PG8_BAR;
        PG8_WAIT_V(4); PG8_BAR;
        PG8_STAGE(PG8_SB(1, 0), cB + kstep, voffB); PG8_STAGE(PG8_SA(1, 0), cA + kstep, voffA); PG8_STAGE(PG8_SB(1, 1), cB + hstep + kstep, voffB);
        PG8_WAIT_V(6); PG8_BAR;
    }
    for (;;) {
        const bool has_next = S.next(ui + 1, nxt);
        const char* nA = has_next ? (const char*)g.A + (size_t)nxt.pm * tstep : cA; const char* nB = has_next ? (const char*)g.Bt + (size_t)nxt.e * g.bstride * 2 + (size_t)nxt.pn * tstep : cB;
        for (int t = 0; t < nt; t += 2) {
            const bool last = (t == nt - 2);
            const char* a1 = cA + (size_t)(t + 1) * kstep;
            const char* a2 = last ? nA : cA + (size_t)(t + 2) * kstep; const char* b2 = last ? nB : cB + (size_t)(t + 2) * kstep;
            const char* a3 = a2 + kstep; const char* b3 = b2 + kstep;
            if (last && has_next) S.a_ready(nxt);
            if constexpr (SP2) {
            PG8_LDB(B0, 0, 0); PG8_LDB(B1, 0, 1); PG8_SCHED; PG8_LDA(At, 0, 0); PG8_STAGE(PG8_SA(1, 1), a1 + hstep, voffA);
            PG8_WAIT_V(8); PG8_WAIT_L(0); PG8_BAR; PG8_MMA(0, 0, At, B0); PG8_MMA(0, 1, At, B1); PG8_BAR; PG8_SCHED;
            PG8_LDA(At, 0, 1); PG8_STAGE(PG8_SB(0, 0), b2, voffB); PG8_STAGE(PG8_SB(0, 1), b2 + hstep, voffB); PG8_STAGE(PG8_SA(0, 0), a2, voffA);
            PG8_WAIT_V(8); PG8_WAIT_L(0); PG8_BAR; PG8_MMA(1, 0, At, B0); PG8_MMA(1, 1, At, B1); PG8_BAR; PG8_SCHED;
            PG8_LDB(B0, 1, 0); PG8_LDB(B1, 1, 1); PG8_SCHED; PG8_LDA(At, 1, 0); PG8_STAGE(PG8_SA(0, 1), a2 + hstep, voffA);
            PG8_WAIT_V(8); PG8_WAIT_L(0); PG8_BAR; PG8_MMA(0, 0, At, B0); PG8_MMA(0, 1, At, B1); PG8_BAR; PG8_SCHED;
            PG8_LDA(At, 1, 1); PG8_STAGE(PG8_SB(1, 0), b3, voffB); PG8_STAGE(PG8_SB(1, 1), b3 + hstep, voffB); PG8_STAGE(PG8_SA(1, 0), a3, voffA);
            PG8_WAIT_V(8); PG8_WAIT_L(0); PG8_BAR; PG8_MMA(1, 0, At, B0); PG8_MMA(1, 1, At, B1); PG8_BAR; PG8_SCHED;
            } else {
            PG8_LDB(B0, 0, 0); PG8_SCHED; PG8_LDA(At, 0, 0); PG8_STAGE(PG8_SA(1, 1), a1 + hstep, voffA);
            PG8_WAIT_L(8); PG8_BAR; PG8_WAIT_L(0); PG8_MMA(0, 0, At, B0); PG8_BAR; PG8_SCHED;
            PG8_LDB(B1, 0, 1); PG8_STAGE(PG8_SB(0, 0), b2, voffB);
            PG8_BAR; PG8_WAIT_L(0); PG8_MMA(0, 1, At, B1); PG8_BAR;
            PG8_LDA(At, 0, 1); PG8_STAGE(PG8_SA(0, 0), a2, voffA);
            PG8_BAR; PG8_WAIT_L(0); PG8_MMA(1, 0, At, B0); PG8_BAR; PG8_SCHED;
            PG8_STAGE(PG8_SB(0, 1), b2 + hstep, voffB);
            PG8_WAIT_V(6); PG8_BAR; PG8_MMA(1, 1, At, B1); PG8_BAR;
            PG8_LDB(B0, 1, 0); PG8_SCHED; PG8_LDA(At, 1, 0); PG8_STAGE(PG8_SA(0, 1), a2 + hstep, voffA);
            PG8_WAIT_L(8); PG8_BAR; PG8_WAIT_L(0); PG8_MMA(0, 0, At, B0); PG8_BAR; PG8_SCHED;
            PG8_LDB(B1, 1, 1); PG8_STAGE(PG8_SB(1, 0), b3, voffB);
            PG8_BAR; PG8_WAIT_L(0); PG8_MMA(0, 1, At, B1); PG8_BAR;
            PG8_LDA(At, 1, 1); PG8_STAGE(PG8_SA(1, 0), a3, voffA);
            PG8_BAR; PG8_WAIT_L(0); PG8_MMA(1, 0, At, B0); PG8_BAR; PG8_SCHED;
            PG8_STAGE(PG8_SB(1, 1), b3 + hstep, voffB);
            PG8_WAIT_V(6); PG8_BAR; PG8_MMA(1, 1, At, B1); PG8_BAR;
            }
        }
        if constexpr (ALIGN_EPI) { if (wr == 0) PG8_BAR; }
        if constexpr (!Epi::AFTER_DRAIN) { E(acc, cur, wr, wc, fr, fq); S.done(cur); }
        if (!has_next) break;
#pragma unroll
        for (int a = 0; a < 2; ++a)
#pragma unroll
            for (int b = 0; b < 2; ++b)
#pragma unroll
                for (int m = 0; m < 4; ++m)
#pragma unroll
                    for (int n = 0; n < 2; ++n) acc[a][b][m][n] = (f32x4){0.f, 0.f, 0.f, 0.f};
        cur = nxt; cA = nA; cB = nB; ++ui;
        if constexpr (ALIGN_EPI) { if (wr == 1) PG8_BAR; }
    }
    PG8_WAIT_V(0);
    if constexpr (!ALIGN_EPI) { if (wr == 0) PG8_BAR; }
    PG8_BAR;
    if constexpr (Epi::AFTER_DRAIN) { E.fused(acc, cur, wr, wc, fr, fq, lds, wid, lane); S.done(cur); }
#undef PG8_SA
#undef PG8_SB
#undef PG8_STAGE
#undef PG8_LDA
#undef PG8_LDB
#undef PG8_MMA
#undef PG8_WAIT_V
#undef PG8_WAIT_L
#undef PG8_BAR
#undef PG8_SCHED
}
}

#ifndef PG8_SP2
#define PG8_SP2 true
#endif
#ifndef PG8_ALIGN
#define PG8_ALIGN true
#endif
#include <hip/hip_bf16.h>
#include <cmath>
namespace attn_body {
using bf16=__hip_bfloat16;
using bf16x8=__attribute__((ext_vector_type(8)))short;
using s16x4=__attribute__((ext_vector_type(4)))short;
using f32x16=__attribute__((ext_vector_type(16)))float;
using u32x4=__attribute__((ext_vector_type(4)))unsigned;
constexpr int BATCH=4,NHEAD=16,SEQ=4096,D=64,DM=NHEAD*D,DMO=2048;
constexpr int NW=8,QBLK=32,QB=QBLK*NW,KVBLK=64,NQB=SEQ/QB;
constexpr int ATTN_PITCH=DM, ATTN_UNIT_ROWS=QB;
__device__ __forceinline__ int crow(int r,int hi){return (r&3)+8*(r>>2)+4*hi;}
#define SBAR() __builtin_amdgcn_sched_barrier(0)
__device__ __forceinline__ void cmask(f32x16&p0,f32x16&p1,int jb,int qrel,int hi){
  const float NEG=-INFINITY; int kb=64*jb+4*hi;
  #pragma unroll
  for(int r=0;r<16;++r){int kv=kb+(r&3)+8*(r>>2); if(kv>qrel)p0[r]=NEG; if(kv+32>qrel)p1[r]=NEG;}
}

constexpr int NSLOT=3, SLOTB=8192;
constexpr int LDS_K=0, LDS_V=NSLOT*SLOTB, LDS_WS=2*NSLOT*SLOTB, LDS_OST=LDS_WS+NW*64*4, LDS_BYTES=LDS_OST+NW*4096;
constexpr float C2=0.125f*1.4426950408889634f;
__device__ __forceinline__ void glds16(const void*gsrc,unsigned lds_dst){unsigned keep;
  asm volatile("s_mov_b32 %0, m0\n\ts_mov_b32 m0, %2\n\ts_nop 0\n\tglobal_load_lds_dwordx4 %1, off\n\ts_mov_b32 m0, %0":"=&s"(keep):"v"(gsrc),"s"(lds_dst):"memory");}
__device__ __forceinline__ float max3f(float a,float b,float c){float r;asm("v_max3_f32 %0, %1, %2, %3":"=v"(r):"v"(a),"v"(b),"v"(c));return r;}
__device__ __forceinline__ float max2f(float a,float b){float r;asm("v_max_f32_e32 %0, %1, %2":"=v"(r):"v"(a),"v"(b));return r;}
__device__ __forceinline__ float fadd_s(float a,float b){float r;asm("v_add_f32_e32 %0, %1, %2":"=v"(r):"v"(a),"v"(b));return r;}
__device__ __forceinline__ float fsub_s(float a,float b){float r;asm("v_sub_f32_e32 %0, %1, %2":"=v"(r):"v"(a),"v"(b));return r;}
typedef float f32x2_t __attribute__((ext_vector_type(2))); typedef __bf16 bf16x2_t __attribute__((ext_vector_type(2)));
__device__ __forceinline__ unsigned cvtpk_s(float lo,float hi){f32x2_t v={lo,hi};bf16x2_t b=__builtin_convertvector(v,bf16x2_t);return __builtin_bit_cast(unsigned,b);}
#define WAIT_BAR(N) asm volatile("s_waitcnt vmcnt(" #N ") lgkmcnt(0)\n\ts_barrier":::"memory")

__device__ __forceinline__ void qkt(f32x16&p0,f32x16&p1,const char*Kslot,const bf16x8*qr,const f32x16&negm,int r32,int hi){
  const char*kb=Kslot+hi*1024+r32*16;
  #pragma unroll
  for(int d0=0;d0<4;++d0){
    const bf16x8 b0=*reinterpret_cast<const bf16x8*>(kb+d0*2048);
    const bf16x8 b1=*reinterpret_cast<const bf16x8*>(kb+d0*2048+512);
    if(d0==0){p0=__builtin_amdgcn_mfma_f32_32x32x16_bf16(b0,qr[0],negm,0,0,0);p1=__builtin_amdgcn_mfma_f32_32x32x16_bf16(b1,qr[0],negm,0,0,0);}
    else{p0=__builtin_amdgcn_mfma_f32_32x32x16_bf16(b0,qr[d0],p0,0,0,0);p1=__builtin_amdgcn_mfma_f32_32x32x16_bf16(b1,qr[d0],p1,0,0,0);}}
}
typedef __attribute__((address_space(3))) const char* lds_cptr;
typedef short v4i16_t __attribute__((ext_vector_type(4)));
__device__ __forceinline__ void kload8(bf16x8*kf,lds_cptr kp){
  kf[0]=*(const __attribute__((address_space(3))) bf16x8*)(kp);      kf[1]=*(const __attribute__((address_space(3))) bf16x8*)(kp+512);
  kf[2]=*(const __attribute__((address_space(3))) bf16x8*)(kp+2048); kf[3]=*(const __attribute__((address_space(3))) bf16x8*)(kp+2560);
  kf[4]=*(const __attribute__((address_space(3))) bf16x8*)(kp+4096); kf[5]=*(const __attribute__((address_space(3))) bf16x8*)(kp+4608);
  kf[6]=*(const __attribute__((address_space(3))) bf16x8*)(kp+6144); kf[7]=*(const __attribute__((address_space(3))) bf16x8*)(kp+6656);
}
__device__ __forceinline__ void kload2(bf16x8*kf,lds_cptr kp,int j){ kf[2*j]=*(const __attribute__((address_space(3))) bf16x8*)(kp+j*2048); kf[2*j+1]=*(const __attribute__((address_space(3))) bf16x8*)(kp+j*2048+512); }
__device__ __forceinline__ s16x4 vtr(lds_cptr p){ return __builtin_bit_cast(s16x4,__builtin_amdgcn_ds_read_tr16_b64_v4i16((__attribute__((address_space(3))) v4i16_t*)p)); }
__device__ __forceinline__ float rowmax(const f32x16&p0,const f32x16&p1){
  float a=max3f(p0[0],p0[1],p1[0]),b=max3f(p0[2],p0[3],p1[1]);a=max3f(a,p1[2],p1[3]);
  #pragma unroll
  for(int r=4;r<16;r+=4){a=max3f(a,p0[r],p0[r+1]);b=max3f(b,p0[r+2],p0[r+3]);a=max3f(a,p1[r],p1[r+1]);b=max3f(b,p1[r+2],p1[r+3]);}
  const float m=max2f(a,b);
  auto rr=__builtin_amdgcn_permlane32_swap(__float_as_uint(m),__float_as_uint(m),false,false);
  return max2f(__uint_as_float(rr[0]),__uint_as_float(rr[1]));
}
__device__ __forceinline__ void pv(f32x16*o,int vb,bf16x8 pa0,bf16x8 pa1,bf16x8 pa2,bf16x8 pa3){
  #pragma unroll
  for(int d0=0;d0<2;++d0){s16x4 lo[4],hi[4];
    #pragma unroll
    for(int ks=0;ks<4;++ks){
      asm volatile("ds_read_b64_tr_b16 %0,%1 offset:%c2":"=&v"(lo[ks]):"v"(vb),"i"(d0*4096+ks*1024):"memory");
      asm volatile("ds_read_b64_tr_b16 %0,%1 offset:%c2":"=&v"(hi[ks]):"v"(vb),"i"(d0*4096+ks*1024+512):"memory");}
    asm volatile("s_waitcnt lgkmcnt(0)":::"memory");SBAR();
    #define PK(k) (bf16x8){lo[k][0],lo[k][1],lo[k][2],lo[k][3],hi[k][0],hi[k][1],hi[k][2],hi[k][3]}
    o[d0]=__builtin_amdgcn_mfma_f32_32x32x16_bf16(pa0,PK(0),o[d0],0,0,0);
    o[d0]=__builtin_amdgcn_mfma_f32_32x32x16_bf16(pa1,PK(1),o[d0],0,0,0);
    o[d0]=__builtin_amdgcn_mfma_f32_32x32x16_bf16(pa2,PK(2),o[d0],0,0,0);
    o[d0]=__builtin_amdgcn_mfma_f32_32x32x16_bf16(pa3,PK(3),o[d0],0,0,0);
    #undef PK
  }
}

#ifndef ATTN_STORE16
#define ATTN_STORE16(p,v) (*(u32x4*)(p)=(v))
#endif
template<int THRL> __device__ __forceinline__ void attn_unit(int b,int hq,int hv,int ho,int qb,const bf16*Q,const bf16*__restrict__ K,const bf16*__restrict__ V,bf16*O,char*shm){
  int tid_=threadIdx.x; asm volatile("":"+v"(tid_)); const int tid=tid_,lane=tid&63,r32=lane&31,hi=lane>>5; const int wid=__builtin_amdgcn_readfirstlane(tid>>6);
  const long rowbase=(long)b*SEQ; const int q0=qb*QB;
  const bf16*Qw=Q+(rowbase+q0+wid*QBLK)*DM+hq*D;
  const bf16*Kh=K+rowbase*DM+hq*D,*Vh=V+rowbase*DM+hv*D;
  const unsigned lds0=(unsigned)(uintptr_t)shm;
  float*wsf=(float*)(shm+LDS_WS)+wid*64;
  const bf16*ksrc=Kh+(long)lane*DM+wid*8;
  const bf16*vsrc=Vh+(long)(16*(wid&3)+(lane>>2))*DM+(wid>>2)*32+(lane&3)*8;
  const unsigned kdst=lds0+LDS_K+wid*1024, vdst=lds0+LDS_V+wid*1024;
  #define DMA_K(t,slot) glds16(ksrc+(long)(t)*KVBLK*DM,(unsigned)__builtin_amdgcn_readfirstlane(kdst+(slot)))
  #define DMA_V(t,slot) glds16(vsrc+(long)(t)*KVBLK*DM,(unsigned)__builtin_amdgcn_readfirstlane(vdst+(slot)))
  const int vb0=(int)(lds0+LDS_V)+((lane>>4)&1)*32+(lane&3)*8+(4*hi+((lane&15)>>2))*64;
  const char*Kbase=shm+LDS_K; bf16x8 kf[8];
  const lds_cptr shm3=(lds_cptr)shm; const lds_cptr kp0=shm3+LDS_K+hi*1024+r32*16; const lds_cptr vp0=shm3+LDS_V+((lane>>4)&1)*32+(lane&3)*8+(4*hi+((lane&15)>>2))*64;
  const int NT=(q0+QB)/KVBLK;
  DMA_K(0,0);DMA_V(0,0);DMA_K(1,SLOTB);
  bf16x8 qr[4];
  #pragma unroll
  for(int d0=0;d0<4;++d0)qr[d0]=*reinterpret_cast<const bf16x8*>(&Qw[(long)r32*DM+d0*16+hi*8]);
  float mhat=0.f,l_reg=0.f;f32x16 o[2];o[0]=f32x16{};o[1]=f32x16{};f32x16 negm=f32x16{};asm volatile("":"+v"(negm));
  const int qrel=wid*QBLK+r32;
  #define CMASK(P0,P1,t) do{int jb_=(t)-(NT-4); if(jb_>=0)cmask(P0,P1,jb_,qrel,hi);}while(0)
  bool resc=false;
  #define START(P0,P1) do{ const float rm=rowmax(P0,P1); resc=false; \
    { const float dl=rm; mhat=fadd_s(mhat,dl); \
      _Pragma("unroll") for(int r=0;r<16;++r){P0[r]=fsub_s(P0[r],dl);P1[r]=fsub_s(P1[r],dl);} \
      _Pragma("unroll") for(int r=0;r<16;++r)negm[r]=-mhat; asm volatile("":"+v"(negm)); } \
    _Pragma("unroll") for(int r=0;r<16;++r)P0[r]=__builtin_amdgcn_exp2f(P0[r]); }while(0)
  #define RESC() do{ if(resc){ asm volatile("s_waitcnt lgkmcnt(0)":::"memory"); \
      _Pragma("unroll") for(int d_=0;d_<2;++d_) _Pragma("unroll") for(int r=0;r<16;++r)o[d_][r]*=wsf[crow(r,hi)]; } }while(0)
  f32x16 pA0,pA1,pB0,pB1;
  int sl_prev=0,sl_cur=0,sl_next=SLOTB;
  #define ROT() do{sl_prev=sl_cur;sl_cur=sl_next;sl_next=(sl_next==(NSLOT-1)*SLOTB)?0:sl_next+SLOTB;}while(0)
  DMA_K(2,2*SLOTB);
  WAIT_BAR(3);
  qkt(pA0,pA1,Kbase,qr,negm,r32,hi);asm volatile("s_nop 15\n\ts_nop 7":"+v"(pA0),"+v"(pA1));CMASK(pA0,pA1,0);
  START(pA0,pA1);
  _Pragma("unroll") for(int r=0;r<16;++r)pA1[r]=__builtin_amdgcn_exp2f(pA1[r]);
  WAIT_BAR(0);
  DMA_K(3,0);DMA_V(1,SLOTB);
  ROT();
  kload8(kf,kp0+sl_cur);
  WAIT_BAR(2);
  s16x4 vlo[8],vhi[8]; u32x4 pw0,pw1,pw2,pw3;
  #define PKW(P,B) cvtpk_s(P[B],P[B+1])
  #define PAF(k) __builtin_bit_cast(bf16x8,pw##k)
  #define VFR(i) (bf16x8){vlo[i][0],vlo[i][1],vlo[i][2],vlo[i][3],vhi[i][0],vhi[i][1],vhi[i][2],vhi[i][3]}
  #define PIN(x) asm volatile("":"+v"(x))
  #define MX3(a,b,c) __builtin_fmaxf(__builtin_fmaxf((a),(b)),(c))
  #define GAPA(MF,A0,A1,A2,A3,W0,W1,PW) do{ MF; sacc+=A0; sacc+=A1; sacc+=A2; sacc+=A3; PIN(sacc); W0; W1; PIN(PW); SBAR(); }while(0)
  #define EX(v) __builtin_amdgcn_exp2f(v)
  #define GAPB(MF,X,B) do{ MF; X[B]=EX(X[B]); X[B+1]=EX(X[B+1]); X[B+2]=EX(X[B+2]); X[B+3]=EX(X[B+3]); PIN(X); SBAR(); }while(0)
  #define VRD(i) do{ vlo[i]=vtr(vp_+(((i)>>2)*4096+((i)&3)*1024)); vhi[i]=vtr(vp_+(((i)>>2)*4096+((i)&3)*1024+512)); }while(0)
  #define KRD(G,j) do{ if(G){ kload2(kf,kp0+sl_next,j); SBAR(); } }while(0)
  #define STEP(C0,C1,P0,P1,t,GK,GV,GL) do{ SBAR(); \
    const lds_cptr vp_=vp0+sl_prev; \
    VRD(0); SBAR(); float sacc=(P0[0]+P0[1]); \
    GAPA(C0=__builtin_amdgcn_mfma_f32_32x32x16_bf16(kf[0],qr[0],negm,0,0,0), P0[2],P0[3],P0[4],P0[5],     pw0[0]=PKW(P0,0), pw0[1]=PKW(P0,2), pw0); \
    VRD(4); SBAR(); GAPA(C1=__builtin_amdgcn_mfma_f32_32x32x16_bf16(kf[1],qr[0],negm,0,0,0), P0[6],P0[7],P0[8],P0[9],     pw0[2]=PKW(P0,4), pw0[3]=PKW(P0,6), pw0); \
    VRD(1); SBAR(); GAPA(C0=__builtin_amdgcn_mfma_f32_32x32x16_bf16(kf[2],qr[1],C0,0,0,0),   P0[10],P0[11],P0[12],P0[13], pw1[0]=PKW(P0,8), pw1[1]=PKW(P0,10), pw1); \
    VRD(5); SBAR(); GAPA(C1=__builtin_amdgcn_mfma_f32_32x32x16_bf16(kf[3],qr[1],C1,0,0,0),   P0[14],P0[15],P1[0],P1[1],   pw1[2]=PKW(P0,12),pw1[3]=PKW(P0,14), pw1); \
    VRD(2); SBAR(); GAPA(C0=__builtin_amdgcn_mfma_f32_32x32x16_bf16(kf[4],qr[2],C0,0,0,0),   P1[2],P1[3],P1[4],P1[5],     pw2[0]=PKW(P1,0), pw2[1]=PKW(P1,2), pw2); \
    VRD(6); SBAR(); GAPA(C1=__builtin_amdgcn_mfma_f32_32x32x16_bf16(kf[5],qr[2],C1,0,0,0),   P1[6],P1[7],P1[8],P1[9],     pw2[2]=PKW(P1,4), pw2[3]=PKW(P1,6), pw2); \
    VRD(3); SBAR(); GAPA(C0=__builtin_amdgcn_mfma_f32_32x32x16_bf16(kf[6],qr[3],C0,0,0,0),   P1[10],P1[11],P1[12],P1[13], pw3[0]=PKW(P1,8), pw3[1]=PKW(P1,10), pw3); \
    VRD(7); SBAR(); GAPA(C1=__builtin_amdgcn_mfma_f32_32x32x16_bf16(kf[7],qr[3],C1,0,0,0),   P1[14],P1[15],0.f,0.f,       pw3[2]=PKW(P1,12),pw3[3]=PKW(P1,14), pw3); \
    l_reg+=sacc; \
    if(GK){DMA_K((t)+3,sl_cur);} if(GV){DMA_V((t)+1,sl_next);} \
    CMASK(C0,C1,t); \
    { float a=MX3(C0[0],C0[1],C1[0]),b=MX3(C0[2],C0[3],C1[1]); a=MX3(a,C1[2],C1[3]); \
      _Pragma("unroll") for(int r=4;r<16;r+=4){a=MX3(a,C0[r],C0[r+1]);b=MX3(b,C0[r+2],C0[r+3]);a=MX3(a,C1[r],C1[r+1]);b=MX3(b,C1[r+2],C1[r+3]);} \
      float rm=__builtin_fmaxf(a,b); { auto rr=__builtin_amdgcn_permlane32_swap(__float_as_uint(rm),__float_as_uint(rm),false,false); rm=__builtin_fmaxf(__uint_as_float(rr[0]),__uint_as_float(rr[1])); } \
      resc=false; \
      if(__builtin_expect(__any(rm>(float)THRL),0)){ const float dl=__builtin_fmaxf(rm,0.f); mhat+=dl; \
        _Pragma("unroll") for(int r=0;r<16;++r){C0[r]-=dl;C1[r]-=dl;} \
        _Pragma("unroll") for(int r=0;r<16;++r)negm[r]=-mhat; asm volatile("":"+v"(negm)); \
        const float f=__builtin_amdgcn_exp2f(-dl); l_reg*=f; if(hi==0)wsf[r32]=f; resc=true; } } \
    SBAR(); \
    GAPB(o[0]=__builtin_amdgcn_mfma_f32_32x32x16_bf16(PAF(0),VFR(0),o[0],0,0,0), C0,0); \
    GAPB(o[1]=__builtin_amdgcn_mfma_f32_32x32x16_bf16(PAF(0),VFR(4),o[1],0,0,0), C0,4); \
    KRD(GL,0); GAPB(o[0]=__builtin_amdgcn_mfma_f32_32x32x16_bf16(PAF(1),VFR(1),o[0],0,0,0), C0,8); \
    KRD(GL,1); GAPB(o[1]=__builtin_amdgcn_mfma_f32_32x32x16_bf16(PAF(1),VFR(5),o[1],0,0,0), C0,12); \
    KRD(GL,2); GAPB(o[0]=__builtin_amdgcn_mfma_f32_32x32x16_bf16(PAF(2),VFR(2),o[0],0,0,0), C1,0); \
    KRD(GL,3); GAPB(o[1]=__builtin_amdgcn_mfma_f32_32x32x16_bf16(PAF(2),VFR(6),o[1],0,0,0), C1,4); \
    GAPB(o[0]=__builtin_amdgcn_mfma_f32_32x32x16_bf16(PAF(3),VFR(3),o[0],0,0,0), C1,8); \
    GAPB(o[1]=__builtin_amdgcn_mfma_f32_32x32x16_bf16(PAF(3),VFR(7),o[1],0,0,0), C1,12); \
    }while(0)
  int t=1;
  #undef CMASK
  #define CMASK(P0,P1,t) do{}while(0)
  for(;t+5<NT;t+=2){
    STEP(pB0,pB1,pA0,pA1,t,true,true,true);     WAIT_BAR(2); RESC(); ROT();
    STEP(pA0,pA1,pB0,pB1,t+1,true,true,true);   WAIT_BAR(2); RESC(); ROT();
  }
  #undef CMASK
  #define CMASK(P0,P1,t) do{int jb_=(t)-(NT-4); if(jb_>=0)cmask(P0,P1,jb_,qrel,hi);}while(0)
  #define ENDW(tt) do{ if((tt)+3<NT){WAIT_BAR(2);} else if((tt)+2<NT){WAIT_BAR(1);} else {WAIT_BAR(0);} }while(0)
  for(;t+1<NT;t+=2){
    STEP(pB0,pB1,pA0,pA1,t,(t+3<NT),(t+1<NT),(t+1<NT));       ENDW(t);   RESC(); ROT();
    STEP(pA0,pA1,pB0,pB1,t+1,(t+4<NT),(t+2<NT),(t+2<NT));     ENDW(t+1); RESC(); ROT();
  }
  STEP(pB0,pB1,pA0,pA1,NT-1,false,false,false); RESC();
  { float sacc=pB0[0]+pB0[1]; _Pragma("unroll") for(int r=2;r<16;++r)sacc+=pB0[r]; _Pragma("unroll") for(int r=0;r<16;++r)sacc+=pB1[r]; l_reg+=sacc;
    pw0=(u32x4){PKW(pB0,0),PKW(pB0,2),PKW(pB0,4),PKW(pB0,6)};pw1=(u32x4){PKW(pB0,8),PKW(pB0,10),PKW(pB0,12),PKW(pB0,14)};pw2=(u32x4){PKW(pB1,0),PKW(pB1,2),PKW(pB1,4),PKW(pB1,6)};pw3=(u32x4){PKW(pB1,8),PKW(pB1,10),PKW(pB1,12),PKW(pB1,14)};
    SBAR(); pv(o,vb0+sl_cur,PAF(0),PAF(1),PAF(2),PAF(3)); }
  #undef PKW
  #undef PAF
  #undef VFR
  #undef PIN
  #undef MX3
  #undef GAPA
  #undef GAPB
  #undef EX
  #undef VRD
  #undef KRD
  #undef STEP
  #undef ENDW
  {auto rr=__builtin_amdgcn_permlane32_swap(__float_as_uint(l_reg),__float_as_uint(l_reg),false,false);l_reg=__uint_as_float(rr[0])+__uint_as_float(rr[1]);}
  if(hi==0)wsf[32+r32]=l_reg;asm volatile("s_waitcnt lgkmcnt(0)":::"memory");
  float rli[16];
  #pragma unroll
  for(int r=0;r<16;++r)rli[r]=__builtin_amdgcn_rcpf(wsf[32+crow(r,hi)]);
  bf16*Ow=O+(rowbase+q0+wid*QBLK)*DMO+ho*D;
  { bf16*stg=(bf16*)(shm+LDS_OST)+wid*2048;
    #pragma unroll
    for(int r=0;r<16;++r){const int orow=crow(r,hi);
      #pragma unroll
      for(int d0=0;d0<2;++d0)stg[orow*64+d0*32+r32]=__float2bfloat16(o[d0][r]*rli[r]);}
    asm volatile("s_waitcnt lgkmcnt(0)":::"memory");
    #pragma unroll
    for(int i=0;i<4;++i){const int row=i*8+(lane>>3),ch=lane&7; const u32x4 v=*(const u32x4*)(stg+row*64+ch*8); ATTN_STORE16(Ow+(long)row*DMO+ch*8,v);} }
  asm volatile("s_waitcnt lgkmcnt(0)\n\ts_barrier":::"memory");
  #undef DMA_K
  #undef DMA_V
  #undef CMASK
  #undef START
  #undef RESC
  #undef ROT
}
constexpr int ATTN_LDS_BYTES=LDS_BYTES;
struct AttnTensors { const bf16* Q; const bf16* K; const bf16* V; bf16* O; };
struct AttnUnit { int b, hq, hv, ho, qb; };
struct StaticOrder {
  int vcu;
  __device__ __forceinline__ explicit StaticOrder(int grid,int block):vcu((block%8)*(grid/8)+block/8){}
  __device__ __forceinline__ bool next(int i,AttnUnit&u)const{ if(i>=8)return false; const int st=vcu>>1, s=4*(vcu&1)+(i>>1); const int h=(st>>2)&7, c=(st>>1)&1, vh=st&1; u.b=st>>5; u.hq=2*h+c; u.hv=2*h+vh; u.ho=(2*h+c)*2+vh; u.qb=(i&1)?15-s:s; return true; }
  __device__ __forceinline__ void a_ready(const AttnUnit&)const{}
  __device__ __forceinline__ void done(const AttnUnit&)const{}
};
template<class Sched,int THRL=8> __device__ __forceinline__ void attn_phase(char*lds,const AttnTensors&T,const Sched&S){
  AttnUnit u;
  for(int i=0;S.next(i,u);++i){ S.a_ready(u); attn_unit<THRL>(u.b,u.hq,u.hv,u.ho,u.qb,T.Q,T.K,T.V,T.O,lds); S.done(u); }
}
#undef SBAR
#undef WAIT_BAR
}
#define GAS __attribute__((address_space(1)))
#define LAS __attribute__((address_space(3)))
typedef unsigned short bf16;
typedef unsigned v4u __attribute__((ext_vector_type(4)));
typedef float f32x4 __attribute__((ext_vector_type(4)));
typedef short bf16x8 __attribute__((ext_vector_type(8)));
typedef GAS unsigned gu32;
typedef GAS unsigned long long gu64;
#define RLX_AGENT __ATOMIC_RELAXED, __HIP_MEMORY_SCOPE_AGENT
#define LDS_WAIT() asm volatile("s_waitcnt lgkmcnt(0)" ::: "memory")
#define VM_WAIT() asm volatile("s_waitcnt vmcnt(0)" ::: "memory")
__device__ __forceinline__ unsigned long long rt() { return __builtin_amdgcn_s_memrealtime(); }
__device__ __forceinline__ unsigned f2bf(float f) { unsigned u = __builtin_bit_cast(unsigned, f); return (u + 0x7fffu + ((u >> 16) & 1u)) >> 16; }
__device__ __forceinline__ unsigned pk2(float lo, float hi) { return f2bf(lo) | (f2bf(hi) << 16); }

#define XB_TMO      128
#define XB_XCNT(j)  (256  + 64 * (j))
#define XB_XSUB(j)  (1280 + 64 * (j))
#define XB_XGEN(j)  (2304 + 64 * (j))
#define XB_TOP      3328
#define XB_TOPGEN   3392
#define XCD_BAR_WORDS 3456
#define XB_SPIN_CAP (1u << 18)

__device__ __forceinline__ unsigned xb_ld(unsigned* p)              { return __hip_atomic_load(p, __ATOMIC_RELAXED, __HIP_MEMORY_SCOPE_AGENT); }
__device__ __forceinline__ unsigned xb_add(unsigned* p, unsigned v) { return __hip_atomic_fetch_add(p, v, __ATOMIC_RELAXED, __HIP_MEMORY_SCOPE_AGENT); }
__device__ __forceinline__ unsigned xb_xcc_id() { return (unsigned)__builtin_amdgcn_s_getreg((3 << 11) | 20) & 0xFu; }
#define XB_SPIN(cond, bar) do { unsigned _sp = 0; while (cond) { __builtin_amdgcn_s_sleep(1); \
    if ((++_sp & 255u) == 0u) { if (xb_ld(&(bar)[XB_TMO])) break; if (_sp > XB_SPIN_CAP) { atomicAdd(&(bar)[XB_TMO], 1u); break; } } } } while (0)

struct XcdBarrier {
    unsigned* bar; unsigned x;
    volatile LAS unsigned* st;
};

__device__ __forceinline__ XcdBarrier xcd_barrier_post(unsigned* bar, volatile LAS unsigned* st) {
    XcdBarrier b; b.bar = bar; b.x = xb_xcc_id(); b.st = st;
    if (threadIdx.x == 0) (void)xb_add(&bar[XB_XCNT(b.x)], 1u);
    return b;
}
__device__ __forceinline__ void xcd_barrier_complete(unsigned* bar, unsigned x, unsigned& nloc, unsigned& nx) {
    const unsigned G = gridDim.x * gridDim.y * gridDim.z;
    unsigned sum, cnt, mine, sp = 0u;
    for (;;) {
        sum = 0u; cnt = 0u; mine = 0u;
#pragma unroll
        for (unsigned j = 0; j < 16; ++j) { const unsigned c = xb_ld(&bar[XB_XCNT(j)]); sum += c; cnt += (c > 0u) ? 1u : 0u; mine = (j == x) ? c : mine; }
        if (sum == G) break;
        __builtin_amdgcn_s_sleep(1);
        if ((++sp & 255u) == 0u) { if (xb_ld(&bar[XB_TMO])) break; if (sp > XB_SPIN_CAP) { atomicAdd(&bar[XB_TMO], 1u); break; } }
    }
    nloc = mine > 0u ? mine : 1u; nx = cnt > 0u ? cnt : 1u;
}

__device__ __forceinline__ void xcd_barrier(const XcdBarrier& b) {
    asm volatile("s_waitcnt vmcnt(0)" ::: "memory");
    __syncthreads();
    if (threadIdx.x == 0) {
        unsigned* bar = b.bar;
        __builtin_amdgcn_s_waitcnt(0);
        unsigned nloc = b.st[0], nx = b.st[1];
        if (nloc == 0u) { xcd_barrier_complete(bar, b.x, nloc, nx); b.st[0] = nloc; b.st[1] = nx; }
        const unsigned old = xb_add(&bar[XB_XSUB(b.x)], 1u);
        const unsigned gen = old / nloc;
        if (old + 1u == (gen + 1u) * nloc) {
            __builtin_amdgcn_fence(__ATOMIC_RELEASE, "agent");
            asm volatile("s_waitcnt vmcnt(0)" ::: "memory");
            const unsigned og = xb_add(&bar[XB_TOP], 1u);
            const unsigned tg = og / nx;
            if (og + 1u == (tg + 1u) * nx) xb_add(&bar[XB_TOPGEN], 1u);
            else XB_SPIN(xb_ld(&bar[XB_TOPGEN]) == tg, bar);
            __builtin_amdgcn_fence(__ATOMIC_ACQUIRE, "agent");
            xb_add(&bar[XB_XGEN(b.x)], 1u);
            asm volatile("s_waitcnt vmcnt(0)" ::: "memory");
        } else {
            XB_SPIN(xb_ld(&bar[XB_XGEN(b.x)]) == gen, bar);
            __builtin_amdgcn_fence(__ATOMIC_ACQUIRE, "agent");
            asm volatile("s_waitcnt vmcnt(0)" ::: "memory");
        }
    }
    __syncthreads();
}

constexpr int NWAVES = 8;
constexpr int BATCH = 4, SEQ = 4096, D = 1024, M = BATCH * SEQ;
constexpr int ZC = 2576, ZN = 2816;
constexpr int FF = 2816, FF2 = 2 * FF;
constexpr int NE = 8, ED = 3584, ED2 = 2 * ED;
constexpr int PLE = 256;
constexpr int MOE_CB = 46;
constexpr int MOE_MAXB = 136;
constexpr float LN_EPS = 1e-5f;
constexpr float DN_ALPHA = 1.4142135623730951f;
constexpr float LAMBDA_INIT = 0.35550906759096926f;
constexpr int ZU = 0, ZV = 512, ZQ = 1024, ZK = 1280, ZVB = 1536, ZR = 2048, ZG = 2560;

constexpr size_t MiB = 1u << 20;
constexpr size_t WS_CTL = 0, CTL_ZERO_BYTES = 1 * MiB;
constexpr size_t WS_LISTS = 1 * MiB;
constexpr size_t WS_TOKINFO = 1 * MiB + 512 * 1024;
constexpr size_t WS_DECAY = 2 * MiB;
constexpr size_t WS_W_IN = 4 * MiB, WS_W_EOUT = WS_W_IN + (size_t)ZN * D * 2, WS_W_FGU = WS_W_EOUT + 2 * MiB, WS_W_FD = WS_W_FGU + (size_t)FF2 * D * 2,
                 WS_W_QKV = WS_W_FD + (size_t)D * FF * 2, WS_W_OOUT = WS_W_QKV + 6 * MiB, WS_W_PG = WS_W_OOUT + 2 * MiB, WS_W_PP = WS_W_PG + 4 * MiB,
                 WS_W_XGU = WS_W_PP + 1 * MiB, WS_W_XD = WS_W_XGU + (size_t)NE * ED2 * D * 2, WS_W_END = WS_W_XD + (size_t)NE * D * ED * 2;
static_assert(WS_W_END == 209 * MiB, "weight map");
constexpr size_t WS_XB0 = 209 * MiB, WS_XB1 = 241 * MiB, WS_PB = 273 * MiB, WS_PP = 289 * MiB, WS_S = 321 * MiB;
constexpr size_t WS_ZB = WS_S, WS_MIX = WS_S + 88 * MiB, WS_KVC = WS_S + 120 * MiB, WS_SPREV = WS_S + 152 * MiB;
constexpr size_t WS_PRE = WS_S;
constexpr size_t WS_HB = WS_S + 64 * MiB;
constexpr size_t WS_QKV = WS_S, WS_OP = WS_S + 96 * MiB;
constexpr size_t WS_XIN = WS_S, WS_H = WS_S + 23 * MiB, WS_Y = WS_S + 104 * MiB;
constexpr size_t WS_END = 500 * MiB;
static_assert(WS_Y + (size_t)MOE_MAXB * 256 * D * 2 <= WS_END && WS_H + (size_t)MOE_CB * 256 * ED * 2 <= WS_Y && WS_SPREV + 16 * MiB <= WS_END && WS_OP + 64 * MiB <= WS_END && WS_HB + (size_t)M * FF * 2 <= WS_END, "scratch map");
constexpr int CW_BAR = 4096;
constexpr int CW_CNT = 1024;

constexpr int RING_OFF = 0, RING_BYTES = 131072;
constexpr int LDSCTL_OFF = RING_BYTES, MISC_OFF = LDSCTL_OFF + 320;
constexpr int LDS_BYTES = 147456;

typedef GAS f32x4 gf32x4;
__device__ __forceinline__ float bf2f(unsigned short h) { return __uint_as_float((unsigned)h << 16); }
__device__ __forceinline__ float wave_sum(float v) {
#pragma unroll
    for (int o = 1; o < 64; o <<= 1) v += __shfl_xor(v, o);
    return v;
}

__device__ __forceinline__ void tr_item(const float* W, int K, int N, bf16* WT, int mode, int rowadd, LAS float* scr, int item, int lane) {
    const int nblk = (N + 31) / 32, kb = item / nblk, nb = item % nblk, k0 = 64 * kb, n0 = 32 * nb;
    const int nn = n0 + (lane & 31); const bool ok = nn < N;
#pragma unroll 8
    for (int i = 0; i < 32; ++i) { const int kk = 2 * i + (lane >> 5); scr[kk * 33 + (lane & 31)] = ok ? W[(size_t)(k0 + kk) * N + nn] : 0.f; }
    LDS_WAIT(); asm volatile("" ::: "memory");
    const int c = lane & 7;
    const int drow0 = mode ? ((n0 >> 7) * 256 + (n0 & 127) + rowadd) : (n0 + rowadd);
#pragma unroll
    for (int j = 0; j < 4; ++j) { const int n = (lane >> 3) + 8 * j; const LAS float* s = scr + (8 * c) * 33 + n;
        v4u o; o.x = pk2(s[0 * 33], s[1 * 33]); o.y = pk2(s[2 * 33], s[3 * 33]); o.z = pk2(s[4 * 33], s[5 * 33]); o.w = pk2(s[6 * 33], s[7 * 33]);
        if (n0 + n < N) *(GAS v4u*)(WT + (size_t)(drow0 + n) * K + k0 + 8 * c) = o; }
    LDS_WAIT(); asm volatile("" ::: "memory");
}

struct KArgs { const float* in[36]; float* out; unsigned char* ws; };
#define CAS __attribute__((address_space(4)))
__device__ __forceinline__ unsigned long long karg_u64(unsigned off) { asm volatile("" : "+s"(off)); return *(const CAS unsigned long long*)((const CAS char*)__builtin_amdgcn_kernarg_segment_ptr() + off); }
__device__ __forceinline__ const float* karg_in(int i) { return (const float*)karg_u64((unsigned)i * 8u); }
__device__ __forceinline__ float* karg_out() { return (float*)karg_u64(36u * 8u); }
__device__ __forceinline__ unsigned char* karg_ws() { return (unsigned char*)karg_u64(37u * 8u); }
struct KA { unsigned char* ws; };

__device__ __forceinline__ void p0_prologue(const KA& a, LAS unsigned char* lds, int vcu, int G, int wave, int lane) {
    unsigned char* ws = a.ws;
    LAS float* scr = (LAS float*)(lds + RING_OFF + wave * 16384);
    const int gw = vcu * NWAVES + wave, NGW = G * NWAVES;
    constexpr int I_IN = 16 * 81, I_SQ = 16 * 32, I_FU = 16 * 88, I_FD = 44 * 32, I_QKV = 16 * 96, I_PP = 4 * 32, I_XU = 16 * 112, I_XD = 56 * 32;
    constexpr int N_DENSE = I_IN + I_SQ + 3 * I_FU + I_QKV + I_SQ + 2 * I_SQ + 2 * I_PP;
    constexpr int NITEMS = N_DENSE + 8 * (2 * I_XU + I_XD);
    for (int it = gw; it < NITEMS; it += NGW) {
        int r = it;
        if (r >= N_DENSE) { r -= N_DENSE; const int e = r / (2 * I_XU + I_XD); r -= e * (2 * I_XU + I_XD);
            if (r < I_XU) { tr_item(karg_in(28) + (size_t)e * D * ED, D, ED, (bf16*)(ws + WS_W_XGU) + (size_t)e * ED2 * D, 1, 0, scr, r, lane); continue; } r -= I_XU;
            if (r < I_XU) { tr_item(karg_in(29) + (size_t)e * D * ED, D, ED, (bf16*)(ws + WS_W_XGU) + (size_t)e * ED2 * D, 1, 128, scr, r, lane); continue; } r -= I_XU;
            tr_item(karg_in(30) + (size_t)e * ED * D, ED, D, (bf16*)(ws + WS_W_XD) + (size_t)e * D * ED, 0, 0, scr, r, lane); continue; }
        if (r < I_IN) { tr_item(karg_in(2), D, ZC, (bf16*)(ws + WS_W_IN), 0, 0, scr, r, lane); continue; } r -= I_IN;
        if (r < I_SQ) { tr_item(karg_in(10), D, D, (bf16*)(ws + WS_W_EOUT), 0, 0, scr, r, lane); continue; } r -= I_SQ;
        if (r < I_FU) { tr_item(karg_in(13), D, FF, (bf16*)(ws + WS_W_FGU), 1, 0, scr, r, lane); continue; } r -= I_FU;
        if (r < I_FU) { tr_item(karg_in(14), D, FF, (bf16*)(ws + WS_W_FGU), 1, 128, scr, r, lane); continue; } r -= I_FU;
        if (r < I_FD) { tr_item(karg_in(15), FF, D, (bf16*)(ws + WS_W_FD), 0, 0, scr, r, lane); continue; } r -= I_FD;
        if (r < I_QKV) { tr_item(karg_in(18), D, 3 * D, (bf16*)(ws + WS_W_QKV), 0, 0, scr, r, lane); continue; } r -= I_QKV;
        if (r < I_SQ) { tr_item(karg_in(24), D, D, (bf16*)(ws + WS_W_OOUT), 0, 0, scr, r, lane); continue; } r -= I_SQ;
        if (r < I_SQ) { tr_item(karg_in(34), D, D, (bf16*)(ws + WS_W_PG), 0, 0, scr, r, lane); continue; } r -= I_SQ;
        if (r < I_SQ) { tr_item(karg_in(34) + (size_t)D * D, D, D, (bf16*)(ws + WS_W_PG) + (size_t)D * D, 0, 0, scr, r, lane); continue; } r -= I_SQ;
        if (r < I_PP) { tr_item(karg_in(33), PLE, D, (bf16*)(ws + WS_W_PP), 0, 0, scr, r, lane); continue; } r -= I_PP;
        tr_item(karg_in(33) + (size_t)PLE * D, PLE, D, (bf16*)(ws + WS_W_PP) + (size_t)D * PLE, 0, 0, scr, r, lane);
    }
    const int gt = gw * 64 + lane, NGT = NGW * 64;
    { GAS v4u* z = (GAS v4u*)(ws + WS_W_IN + (size_t)ZC * D * 2); for (int i = gt; i < (ZN - ZC) * D * 2 / 16; i += NGT) z[i] = (v4u){0u, 0u, 0u, 0u}; }
    { const gf32x4* xs = (const gf32x4*)karg_in(0); GAS v4u* xd = (GAS v4u*)(ws + WS_XB0);
      for (int i = gt; i < M * D / 8; i += NGT) { const f32x4 u0 = xs[2 * i], u1 = xs[2 * i + 1]; xd[i] = (v4u){pk2(u0[0], u0[1]), pk2(u0[2], u0[3]), pk2(u1[0], u1[1]), pk2(u1[2], u1[3])}; }
      const gf32x4* ps = (const gf32x4*)karg_in(1); GAS v4u* pd = (GAS v4u*)(ws + WS_PB);
      for (int i = gt; i < 2 * M * PLE / 8; i += NGT) { const f32x4 u0 = ps[2 * i], u1 = ps[2 * i + 1]; pd[i] = (v4u){pk2(u0[0], u0[1]), pk2(u0[2], u0[3]), pk2(u1[0], u1[1]), pk2(u1[2], u1[3])}; } }
}

__device__ __forceinline__ f32x4 mm16(const LAS bf16* A, int lda, const LAS bf16* Bt, int ldb, int K, int lane, f32x4 acc) {
    const int r = lane & 15, q = lane >> 4;
    for (int k = 0; k < K; k += 32) {
        const bf16x8 a = *(const LAS bf16x8*)(A + r * lda + k + 8 * q);
        const bf16x8 b = *(const LAS bf16x8*)(Bt + r * ldb + k + 8 * q);
        acc = __builtin_amdgcn_mfma_f32_16x16x32_bf16(a, b, acc, 0, 0, 0);
    }
    return acc;
}
#define WG_SYNC() __syncthreads()

__device__ __forceinline__ void gmlp_item(const KA& a, LAS unsigned char* lds, int chunk, int tid) {
    const int lane = tid & 63, wave = tid >> 6;
    const bf16* zb = (const bf16*)(a.ws + WS_ZB); bf16* mix = (bf16*)(a.ws + WS_MIX);
    const float* ln_g = karg_in(3); const float* ln_b = karg_in(4); const float* wsp = karg_in(5); const float* bsp = karg_in(6);
    const int t0 = chunk * 128;
    LAS float* stat = (LAS float*)(lds + 96 * 1024);
    LAS bf16* vnT = (LAS bf16*)lds;
    constexpr int LDV = 136;
    { const int row = tid >> 2, part = tid & 3; const bf16* vp = zb + (size_t)(t0 + row) * ZN + ZV + part * 128;
      float s = 0.f, s2 = 0.f;
#pragma unroll
      for (int i = 0; i < 16; ++i) { const v4u w = *(const GAS v4u*)(vp + i * 8);
#pragma unroll
          for (int j = 0; j < 4; ++j) { const float lo = __uint_as_float(w[j] << 16), hi = __uint_as_float(w[j] & 0xffff0000u); s += lo + hi; s2 += lo * lo + hi * hi; } }
      s += __shfl_xor(s, 1); s += __shfl_xor(s, 2); s2 += __shfl_xor(s2, 1); s2 += __shfl_xor(s2, 2);
      const float mean = s * (1.f / 512.f), var = s2 * (1.f / 512.f) - mean * mean;
      if (part == 0) { stat[row * 2] = mean; stat[row * 2 + 1] = 1.0f / sqrtf(fmaxf(var, 0.f) + LN_EPS); } }
    WG_SYNC();
    for (int hh = 0; hh < 2; ++hh) {
        for (int i = tid; i < 128 * 32; i += 512) { const int s = i >> 5, c8 = (i & 31) * 8; const int ch = hh * 256 + c8;
            const v4u w = *(const GAS v4u*)(zb + (size_t)(t0 + s) * ZN + ZV + ch); const float mean = stat[s * 2], rstd = stat[s * 2 + 1];
#pragma unroll
            for (int j = 0; j < 4; ++j) { const float lo = __uint_as_float(w[j] << 16), hi = __uint_as_float(w[j] & 0xffff0000u);
                vnT[(c8 + 2 * j) * LDV + s] = (bf16)f2bf((lo - mean) * rstd * ln_g[ch + 2 * j] + ln_b[ch + 2 * j]);
                vnT[(c8 + 2 * j + 1) * LDV + s] = (bf16)f2bf((hi - mean) * rstd * ln_g[ch + 2 * j + 1] + ln_b[ch + 2 * j + 1]); } }
        WG_SYNC();
        const int r = lane & 15, q = lane >> 4, trow = wave * 16 + r;
        for (int gl = 0; gl < 4; ++gl) { const int g = hh * 4 + gl;
            f32x4 acc[4];
#pragma unroll
            for (int dt = 0; dt < 4; ++dt) acc[dt] = (f32x4){0.f, 0.f, 0.f, 0.f};
            const float* wrow = wsp + ((size_t)g * 128 + trow) * 128;
            const int nks = (wave * 16 + 15) / 32 + 1;
            for (int ks = 0; ks < nks; ++ks) { const int k0 = ks * 32 + 8 * q;
                const f32x4 w0 = *(const gf32x4*)(wrow + k0), w1 = *(const gf32x4*)(wrow + k0 + 4);
                bf16x8 af;
#pragma unroll
                for (int j = 0; j < 4; ++j) { af[j] = (short)f2bf((k0 + j <= trow) ? w0[j] : 0.f); af[4 + j] = (short)f2bf((k0 + 4 + j <= trow) ? w1[j] : 0.f); }
#pragma unroll
                for (int dt = 0; dt < 4; ++dt) { const bf16x8 b = *(const LAS bf16x8*)(vnT + (gl * 64 + dt * 16 + r) * LDV + k0);
                    acc[dt] = __builtin_amdgcn_mfma_f32_16x16x32_bf16(af, b, acc[dt], 0, 0, 0); } }
#pragma unroll
            for (int i = 0; i < 4; ++i) { const int t = wave * 16 + 4 * q + i; const float bias = bsp[g * 128 + t];
#pragma unroll
                for (int dt = 0; dt < 4; ++dt) { const int col = g * 64 + dt * 16 + r; const float u = bf2f(zb[(size_t)(t0 + t) * ZN + ZU + col]);
                    mix[(size_t)(t0 + t) * D + col] = (bf16)f2bf(u * (acc[dt][i] + bias)); } } }
        WG_SYNC();
    }
}

__device__ __forceinline__ void gla_bcum(const KA& a, LAS unsigned char* lds, int t0, int h, int tid, LAS float* bc  , LAS float* tmp  ) {
    const int lane = tid & 63, wave = tid >> 6;
    const bf16* zb = (const bf16*)(a.ws + WS_ZB);
    LAS float* gl = tmp; LAS float* wg = tmp + 64 * 16;
    for (int i = tid; i < 64 * 16; i += 512) { const int l = i >> 4, j = i & 15; gl[i] = bf2f(zb[(size_t)(t0 + l) * ZN + ZG + j]); }
    const float* wgu = karg_in(7); const float* bgt = karg_in(8);
    for (int i = tid; i < 16 * 64; i += 512) { const int j = i >> 6, d = i & 63; wg[i] = wgu[j * 256 + h * 64 + d]; }
    WG_SYNC();
#pragma unroll
    for (int dd = 0; dd < 8; ++dd) { const int d = wave * 8 + dd; float s = bgt[h * 64 + d];
#pragma unroll
        for (int j = 0; j < 16; ++j) s += gl[lane * 16 + j] * wg[j * 64 + d];
        float la = (fminf(s, 0.f) - log1pf(__expf(-fabsf(s)))) * (1.0f / 16.0f);
#pragma unroll
        for (int o = 1; o < 64; o <<= 1) { const float v = __shfl_up(la, o); if (lane >= o) la += v; }
        bc[lane * 65 + d] = la; }
    WG_SYNC();
}

__device__ __forceinline__ void gla_kv_item(const KA& a, LAS unsigned char* lds, int item, int tid) {
    const int lane = tid & 63, wave = tid >> 6;
    const int h = item & 3, c = (item >> 2) & 63, b = item >> 8, t0 = b * SEQ + c * 64;
    const bf16* zb = (const bf16*)(a.ws + WS_ZB);
    LAS float* bc = (LAS float*)lds;
    LAS float* tmp = (LAS float*)(lds + 17408);
    LAS bf16* kdT = (LAS bf16*)(lds + 32768);
    LAS bf16* vT = (LAS bf16*)(lds + 32768 + 64 * 72 * 2);
    gla_bcum(a, lds, t0, h, tid, bc, tmp);
    for (int i = tid; i < 64 * 64; i += 512) { const int l = i >> 6, d = i & 63; const float kk = bf2f(zb[(size_t)(t0 + l) * ZN + ZK + h * 64 + d]);
        kdT[d * 72 + l] = (bf16)f2bf(kk * __expf(bc[63 * 65 + d] - bc[l * 65 + d])); }
    for (int i = tid; i < 64 * 128; i += 512) { const int l = i >> 7, e = i & 127; vT[e * 72 + l] = zb[(size_t)(t0 + l) * ZN + ZVB + h * 128 + e]; }
    if (tid < 64) ((float*)(a.ws + WS_DECAY))[item * 64 + tid] = __expf(bc[63 * 65 + tid]);
    WG_SYNC();
    const int dt = wave & 3, r = lane & 15, q = lane >> 4;
    float* kvc = (float*)(a.ws + WS_KVC) + (size_t)item * 64 * 128;
#pragma unroll
    for (int j = 0; j < 4; ++j) { const int et = (wave >> 2) * 4 + j;
        f32x4 acc = mm16(kdT + dt * 16 * 72, 72, vT + et * 16 * 72, 72, 64, lane, (f32x4){0.f, 0.f, 0.f, 0.f});
#pragma unroll
        for (int i = 0; i < 4; ++i) kvc[(dt * 16 + 4 * q + i) * 128 + et * 16 + r] = acc[i]; }
    WG_SYNC();
}

__device__ __forceinline__ void gla_scan(const KA& a, int gtid, int ngt) {
    const float* kvc = (const float*)(a.ws + WS_KVC); const float* dec = (const float*)(a.ws + WS_DECAY); bf16* sp = (bf16*)(a.ws + WS_SPREV);
    for (int idx = gtid; idx < BATCH * 4 * 64 * 128; idx += ngt) { const int e = idx & 127, d = (idx >> 7) & 63, h = (idx >> 13) & 3, b = idx >> 15;
        float S = 0.f;
#pragma unroll 8
        for (int c = 0; c < 64; ++c) { const int item = (b * 64 + c) * 4 + h; const size_t o = (size_t)item * 8192 + d * 128 + e;
            sp[o] = (bf16)f2bf(S); S = dec[item * 64 + d] * S + kvc[o]; } }
}

__device__ __forceinline__ void gla_out_item(const KA& a, LAS unsigned char* lds, int item, int tid) {
    const int lane = tid & 63, wave = tid >> 6;
    const int h = item & 3, c = (item >> 2) & 63, b = item >> 8, t0 = b * SEQ + c * 64;
    const bf16* zb = (const bf16*)(a.ws + WS_ZB); bf16* mix = (bf16*)(a.ws + WS_MIX);
    LAS float* bc = (LAS float*)lds;
    LAS float* tmp = (LAS float*)(lds + 17408);
    LAS bf16* qd = (LAS bf16*)(lds + 32768);
    LAS bf16* kd2 = qd + 64 * 72;
    LAS bf16* qb = kd2 + 64 * 72;
    LAS bf16* sc = qb + 64 * 72;
    LAS bf16* vT = sc + 64 * 72;
    LAS bf16* sT = vT + 128 * 72;
    gla_bcum(a, lds, t0, h, tid, bc, tmp);
    for (int i = tid; i < 64 * 64; i += 512) { const int l = i >> 6, d = i & 63; const float bl = bc[l * 65 + d], br = bc[31 * 65 + d];
        const float qq = bf2f(zb[(size_t)(t0 + l) * ZN + ZQ + h * 64 + d]), kk = bf2f(zb[(size_t)(t0 + l) * ZN + ZK + h * 64 + d]);
        qd[l * 72 + d] = (bf16)f2bf(qq * __expf(bl - br)); kd2[l * 72 + d] = (bf16)f2bf(kk * __expf(br - bl)); qb[l * 72 + d] = (bf16)f2bf(qq * __expf(bl)); }
    const bf16* sp = (const bf16*)(a.ws + WS_SPREV) + (size_t)item * 8192;
    for (int i = tid; i < 64 * 128; i += 512) { const int l = i >> 7, e = i & 127; vT[e * 72 + l] = zb[(size_t)(t0 + l) * ZN + ZVB + h * 128 + e]; sT[e * 72 + l] = sp[l * 128 + e]; }
    WG_SYNC();
    const int r = lane & 15, q = lane >> 4;
    { const int lt = wave >> 1;
#pragma unroll
      for (int j = 0; j < 2; ++j) { const int mt = (wave & 1) * 2 + j;
          f32x4 acc = mm16(qd + lt * 16 * 72, 72, kd2 + mt * 16 * 72, 72, 64, lane, (f32x4){0.f, 0.f, 0.f, 0.f});
#pragma unroll
          for (int i = 0; i < 4; ++i) { const int l = lt * 16 + 4 * q + i, m = mt * 16 + r; sc[l * 72 + m] = (bf16)f2bf(m <= l ? acc[i] : 0.f); } } }
    WG_SYNC();
    const int lt = wave >> 1; f32x4 o[4]; float ssq[4] = {0.f, 0.f, 0.f, 0.f};
#pragma unroll
    for (int j = 0; j < 4; ++j) { const int et = (wave & 1) * 4 + j;
        o[j] = mm16(sc + lt * 16 * 72, 72, vT + et * 16 * 72, 72, 64, lane, (f32x4){0.f, 0.f, 0.f, 0.f});
        o[j] = mm16(qb + lt * 16 * 72, 72, sT + et * 16 * 72, 72, 64, lane, o[j]);
#pragma unroll
        for (int i = 0; i < 4; ++i) ssq[i] += o[j][i] * o[j][i]; }
    LAS float* ss = tmp;
#pragma unroll
    for (int i = 0; i < 4; ++i) { float v = ssq[i]; v += __shfl_xor(v, 1); v += __shfl_xor(v, 2); v += __shfl_xor(v, 4); v += __shfl_xor(v, 8);
        if (r == 0) ss[(wave & 1) * 64 + lt * 16 + 4 * q + i] = v; }
    WG_SYNC();
    const float* ng = karg_in(9);
#pragma unroll
    for (int i = 0; i < 4; ++i) { const int l = lt * 16 + 4 * q + i; const float rstd = 1.0f / sqrtf((ss[l] + ss[64 + l]) * (1.f / 128.f) + LN_EPS);
#pragma unroll
        for (int j = 0; j < 4; ++j) { const int e = ((wave & 1) * 4 + j) * 16 + r; const float rr = bf2f(zb[(size_t)(t0 + l) * ZN + ZR + h * 128 + e]);
            mix[(size_t)(t0 + l) * D + 512 + h * 128 + e] = (bf16)f2bf(o[j][i] * rstd * ng[e] * pg8::silu_f(rr)); } }
    WG_SYNC();
}

__device__ __forceinline__ void ln_apply_store(f32x4 (&v)[4], const float* g, const float* bta, float* of, bf16* ob, int lane) {
    float s = 0.f;
#pragma unroll
    for (int j = 0; j < 4; ++j) s += (v[j][0] + v[j][1]) + (v[j][2] + v[j][3]);
    const float mean = wave_sum(s) * (1.f / D); float s2 = 0.f;
#pragma unroll
    for (int j = 0; j < 4; ++j) { v[j] = v[j] - mean; s2 += (v[j][0] * v[j][0] + v[j][1] * v[j][1]) + (v[j][2] * v[j][2] + v[j][3] * v[j][3]); }
    const float rstd = 1.0f / sqrtf(wave_sum(s2) * (1.f / D) + LN_EPS);
#pragma unroll
    for (int j = 0; j < 4; ++j) { const f32x4 gg = *(const gf32x4*)(g + 4 * lane + 256 * j), bb = *(const gf32x4*)(bta + 4 * lane + 256 * j);
        v[j] = v[j] * rstd * gg + bb;
        *(gf32x4*)(of + 4 * lane + 256 * j) = v[j];
        *(GAS unsigned long long*)(ob + 4 * lane + 256 * j) = (unsigned long long)pk2(v[j][0], v[j][1]) | ((unsigned long long)pk2(v[j][2], v[j][3]) << 32); }
}
__device__ __forceinline__ void ln_pass(const float* pre, const float* g, const float* bta, float* of, bf16* ob, int gw, int ngw, int lane) {
    for (int m = gw; m < M; m += ngw) { f32x4 v[4];
#pragma unroll
        for (int j = 0; j < 4; ++j) v[j] = *(const gf32x4*)(pre + (size_t)m * D + 4 * lane + 256 * j);
        ln_apply_store(v, g, bta, of + (size_t)m * D, ob + (size_t)m * D, lane); }
}
__device__ __forceinline__ void ln_router_pass(const KA& a, LAS unsigned char* lds, const float* pre, float* of, bf16* ob, int gw, int ngw, int lane, int tid) {
    LAS float* wr = (LAS float*)lds;
    for (int i = tid; i < D * NE / 4; i += 512) ((LAS f32x4*)wr)[i] = ((const gf32x4*)karg_in(27))[i];
    WG_SYNC();
    unsigned* cnt = (unsigned*)(a.ws + WS_CTL) + CW_CNT; int* lists = (int*)(a.ws + WS_LISTS); int* tinfo = (int*)(a.ws + WS_TOKINFO);
    const float* lng = karg_in(25); const float* lnb = karg_in(26);
    for (int m = gw; m < M; m += ngw) { f32x4 v[4];
#pragma unroll
        for (int j = 0; j < 4; ++j) v[j] = *(const gf32x4*)(pre + (size_t)m * D + 4 * lane + 256 * j);
        ln_apply_store(v, lng, lnb, of + (size_t)m * D, ob + (size_t)m * D, lane);
        float lg[8];
#pragma unroll
        for (int e = 0; e < 8; ++e) lg[e] = 0.f;
#pragma unroll
        for (int j = 0; j < 4; ++j)
#pragma unroll
            for (int i = 0; i < 4; ++i) { const int col = 4 * lane + 256 * j + i; const f32x4 w0 = *(const LAS f32x4*)(wr + col * 8), w1 = *(const LAS f32x4*)(wr + col * 8 + 4);
#pragma unroll
                for (int e = 0; e < 4; ++e) { lg[e] += v[j][i] * w0[e]; lg[4 + e] += v[j][i] * w1[e]; } }
#pragma unroll
        for (int e = 0; e < 8; ++e) lg[e] = wave_sum(lg[e]);
        if (lane == 0) {
            int e1 = 0; float v1 = lg[0];
#pragma unroll
            for (int e = 1; e < 8; ++e) if (lg[e] > v1) { v1 = lg[e]; e1 = e; }
            int e2 = -1; float v2 = -INFINITY;
#pragma unroll
            for (int e = 0; e < 8; ++e) if (e != e1 && lg[e] > v2) { v2 = lg[e]; e2 = e; }
            const float g2 = 1.0f / (1.0f + __expf(v1 - v2)), g1 = 1.0f - g2;
            const int p1 = (int)atomicAdd(cnt + e1, 1u), p2 = (int)atomicAdd(cnt + e2, 1u);
            lists[e1 * M + p1] = m; lists[e2 * M + p2] = m;
            int* ti = tinfo + (size_t)m * 8; ti[0] = e1; ti[1] = p1; ti[2] = e2; ti[3] = p2; ((float*)ti)[4] = g1; ((float*)ti)[5] = g2;
        }
    }
}
__device__ __forceinline__ void attn_combine_pass(const KA& a, int gw, int ngw, int lane) {
    const bf16* op = (const bf16*)(a.ws + WS_OP); bf16* ao = (bf16*)(a.ws + WS_XB0);
    const float lam = __expf(wave_sum(karg_in(19)[lane] * karg_in(20)[lane])) - __expf(wave_sum(karg_in(21)[lane] * karg_in(22)[lane])) + LAMBDA_INIT;
    const int h = lane >> 3, e0 = (lane & 7) * 16; const float* sg = karg_in(23);
    for (int m = gw; m < M; m += ngw) { const bf16* p0 = op + (size_t)m * 2048 + h * 256 + e0; const bf16* p1 = p0 + 128;
        float o[16]; float ssq = 0.f;
#pragma unroll
        for (int k = 0; k < 2; ++k) { const v4u w0 = *(const GAS v4u*)(p0 + 8 * k), w1 = *(const GAS v4u*)(p1 + 8 * k);
#pragma unroll
            for (int j = 0; j < 4; ++j) { const float a0 = __uint_as_float(w0[j] << 16), a1 = __uint_as_float(w0[j] & 0xffff0000u), b0 = __uint_as_float(w1[j] << 16), b1 = __uint_as_float(w1[j] & 0xffff0000u);
                const float x0 = a0 - lam * b0, x1 = a1 - lam * b1; o[8 * k + 2 * j] = x0; o[8 * k + 2 * j + 1] = x1; ssq += x0 * x0 + x1 * x1; } }
        ssq += __shfl_xor(ssq, 1); ssq += __shfl_xor(ssq, 2); ssq += __shfl_xor(ssq, 4);
        const float sc = (1.0f / sqrtf(ssq * (1.f / 128.f) + LN_EPS)) * (1.0f - LAMBDA_INIT);
        v4u w[2];
#pragma unroll
        for (int k = 0; k < 2; ++k)
#pragma unroll
            for (int j = 0; j < 4; ++j) w[k][j] = pk2(o[8 * k + 2 * j] * sc * sg[e0 + 8 * k + 2 * j], o[8 * k + 2 * j + 1] * sc * sg[e0 + 8 * k + 2 * j + 1]);
        GAS v4u* dst = (GAS v4u*)(ao + (size_t)m * D + h * 128 + e0); dst[0] = w[0]; dst[1] = w[1]; }
}
__device__ __forceinline__ int moe_setup(const KA& a, volatile LAS unsigned* MISC, int tid) {
    if (tid == 0) { const unsigned* cnt = (const unsigned*)(a.ws + WS_CTL) + CW_CNT; unsigned acc = 0;
        for (int e = 0; e < NE; ++e) { acc += (__hip_atomic_load(cnt + e, __ATOMIC_RELAXED, __HIP_MEMORY_SCOPE_AGENT) + 255u) >> 8; MISC[16 + e] = acc; } }
    WG_SYNC();
    return (int)MISC[16 + NE - 1];
}
__device__ __forceinline__ int moe_blk_expert(volatile LAS unsigned* MISC, int blk) { int e = 0;
#pragma unroll
    for (int i = 0; i < NE - 1; ++i) e += ((unsigned)blk >= MISC[16 + i]) ? 1 : 0;
    return e; }
__device__ __forceinline__ void moe_gather(const KA& a, volatile LAS unsigned* MISC, int b0, int b1, int gw, int ngw, int lane) {
    const unsigned* cnt = (const unsigned*)(a.ws + WS_CTL) + CW_CNT; const int* lists = (const int*)(a.ws + WS_LISTS);
    const bf16* xs = (const bf16*)(a.ws + WS_XB1); bf16* xin = (bf16*)(a.ws + WS_XIN);
    for (int rr = gw; rr < (b1 - b0) * 256; rr += ngw) { const int blk = b0 + (rr >> 8); const int e = moe_blk_expert(MISC, blk); const int pstart = e ? (int)MISC[16 + e - 1] : 0;
        const int li = (blk - pstart) * 256 + (rr & 255); const int n = (int)__hip_atomic_load(cnt + e, __ATOMIC_RELAXED, __HIP_MEMORY_SCOPE_AGENT);
        v4u w0 = (v4u){0u, 0u, 0u, 0u}, w1 = w0;
        if (li < n) { const int tok = lists[e * M + li]; const GAS v4u* s = (const GAS v4u*)(xs + (size_t)tok * D); w0 = s[lane]; w1 = s[64 + lane]; }
        GAS v4u* d = (GAS v4u*)(xin + (size_t)rr * D); d[lane] = w0; d[64 + lane] = w1; }
}
__device__ __forceinline__ void moe_combine_pass(const KA& a, volatile LAS unsigned* MISC, float* of, bf16* ob, int gw, int ngw, int lane) {
    const bf16* y = (const bf16*)(a.ws + WS_Y); const int* tinfo = (const int*)(a.ws + WS_TOKINFO);
    const float* lng = karg_in(31); const float* lnb = karg_in(32);
    for (int m = gw; m < M; m += ngw) { const int* ti = tinfo + (size_t)m * 8; const int e1 = ti[0], p1 = ti[1], e2 = ti[2], p2 = ti[3]; const float g1 = ((const float*)ti)[4], g2 = ((const float*)ti)[5];
        const size_t r1 = (size_t)(e1 ? MISC[16 + e1 - 1] : 0u) * 256 + p1, r2 = (size_t)(e2 ? MISC[16 + e2 - 1] : 0u) * 256 + p2;
        f32x4 v[4];
#pragma unroll
        for (int j = 0; j < 4; ++j) { const f32x4 xv = *(const gf32x4*)(of + (size_t)m * D + 4 * lane + 256 * j);
            const unsigned long long w1 = *(const GAS unsigned long long*)(y + r1 * D + 4 * lane + 256 * j), w2 = *(const GAS unsigned long long*)(y + r2 * D + 4 * lane + 256 * j);
            f32x4 y1, y2; y1[0] = __uint_as_float((unsigned)w1 << 16); y1[1] = __uint_as_float((unsigned)w1 & 0xffff0000u); y1[2] = __uint_as_float((unsigned)(w1 >> 32) << 16); y1[3] = __uint_as_float((unsigned)(w1 >> 32) & 0xffff0000u);
            y2[0] = __uint_as_float((unsigned)w2 << 16); y2[1] = __uint_as_float((unsigned)w2 & 0xffff0000u); y2[2] = __uint_as_float((unsigned)(w2 >> 32) << 16); y2[3] = __uint_as_float((unsigned)(w2 >> 32) & 0xffff0000u);
            v[j] = xv * DN_ALPHA + (y1 * g1 + y2 * g2); }
        ln_apply_store(v, lng, lnb, of + (size_t)m * D, ob + (size_t)m * D, lane); }
}

struct MoeOrder {
    pg8::StaticOrder so; int b0; volatile LAS unsigned* MISC;
    __device__ __forceinline__ void init(int nb, int nN, int G, int c, int b0_, volatile LAS unsigned* misc) { so.nM = nb; so.nN = nN; so.nwg = nb * nN; so.G = G; so.c = c; b0 = b0_; MISC = misc; }
    __device__ __forceinline__ bool next(int i, pg8::Unit& u) const { if (!so.next(i, u)) return false; u.pm += b0; u.e = moe_blk_expert(MISC, u.pm); return true; }
    __device__ __forceinline__ void a_ready(const pg8::Unit&) const {}
    __device__ __forceinline__ void done(const pg8::Unit&) const {}
};

__global__ void __launch_bounds__(NWAVES * 64, 2) mega_fwd(KArgs args_unused) {
    extern __shared__ __attribute__((aligned(16))) unsigned char lds_raw[];
    LAS unsigned char* lds = (LAS unsigned char*)lds_raw;
    volatile LAS unsigned* MISC = (volatile LAS unsigned*)(lds + MISC_OFF);
#define PHASE_IDS() int tid = threadIdx.x; asm volatile("" : "+v"(tid)); const int lane = tid & 63; (void)lane
    const int wave = __builtin_amdgcn_readfirstlane(threadIdx.x >> 6);
    const int G = gridDim.x, bx = blockIdx.x, vcu = (G % 8 == 0) ? (bx % 8) * (G / 8) + bx / 8 : bx;
    unsigned char* ws = karg_ws();
    KA args; args.ws = ws;
    gu32* ctl = (gu32*)(ws + WS_CTL);
    for (int u = threadIdx.x; u < (LDS_BYTES - LDSCTL_OFF) / 4; u += NWAVES * 64) ((LAS unsigned*)(lds + LDSCTL_OFF))[u] = 0u;
    __syncthreads();
    XcdBarrier bar = xcd_barrier_post((unsigned*)(ctl + CW_BAR), MISC + 8);
#define GRID_BAR() xcd_barrier(bar)
    const int gw = vcu * NWAVES + wave, ngw = G * NWAVES;
    float* dout = karg_out();
    bf16* XB0 = (bf16*)(ws + WS_XB0); bf16* XB1 = (bf16*)(ws + WS_XB1); float* PRE = (float*)(ws + WS_PRE);

    { PHASE_IDS(); p0_prologue(args, lds, vcu, G, wave, lane); }
    GRID_BAR();
    { pg8::Gemm g{XB0, (const bf16*)(ws + WS_W_IN), M, ZN, D, 0}; pg8::StaticOrder S; S.init(M, ZN, G, bx);
      pg8::EpiZ E{(bf16*)(ws + WS_ZB), ZN};
      pg8::gemm_phase<pg8::EpiZ, pg8::StaticOrder, PG8_ALIGN, PG8_SP2>(lds + RING_OFF, g, S, E); }
    { pg8::Gemm g{(const bf16*)(ws + WS_PB), (const bf16*)(ws + WS_W_PP), M, D, PLE, 0}; pg8::StaticOrder S; S.init(M, D, G, bx);
      pg8::EpiBf16<0> E{(bf16*)(ws + WS_PP), D, nullptr, 0, 0, 1.f};
      pg8::gemm_phase<pg8::EpiBf16<0>, pg8::StaticOrder, PG8_ALIGN, PG8_SP2>(lds + RING_OFF, g, S, E); }
    GRID_BAR();
    { PHASE_IDS(); for (int it = vcu; it < 128 + 1024; it += G) { if (it < 128) gmlp_item(args, lds, it, tid); else gla_kv_item(args, lds, it - 128, tid); } }
    GRID_BAR();
    { PHASE_IDS(); gla_scan(args, gw * 64 + lane, ngw * 64); }
    GRID_BAR();
    { PHASE_IDS(); for (int it = vcu; it < 1024; it += G) gla_out_item(args, lds, it, tid); }
    GRID_BAR();
    { pg8::Gemm g{(const bf16*)(ws + WS_MIX), (const bf16*)(ws + WS_W_EOUT), M, D, D, 0}; pg8::StaticOrder S; S.init(M, D, G, bx);
      pg8::EpiRes E{karg_in(0), PRE, D, DN_ALPHA};
      pg8::gemm_phase<pg8::EpiRes, pg8::StaticOrder, PG8_ALIGN, PG8_SP2>(lds + RING_OFF, g, S, E); }
    GRID_BAR();
    { PHASE_IDS(); ln_pass(PRE, karg_in(11), karg_in(12), dout, XB1, gw, ngw, lane); }
    GRID_BAR();
    { pg8::Gemm g{XB1, (const bf16*)(ws + WS_W_FGU), M, FF2, D, 0}; pg8::StaticOrder S; S.init(M, FF2, G, bx);
      pg8::EpiGU E{(bf16*)(ws + WS_HB), FF};
      pg8::gemm_phase<pg8::EpiGU, pg8::StaticOrder, PG8_ALIGN, PG8_SP2>(lds + RING_OFF, g, S, E); }
    GRID_BAR();
    { pg8::Gemm g{(const bf16*)(ws + WS_HB), (const bf16*)(ws + WS_W_FD), M, D, FF, 0}; pg8::StaticOrder S; S.init(M, D, G, bx);
      pg8::EpiRes E{dout, PRE, D, DN_ALPHA};
      pg8::gemm_phase<pg8::EpiRes, pg8::StaticOrder, PG8_ALIGN, PG8_SP2>(lds + RING_OFF, g, S, E); }
    GRID_BAR();
    { PHASE_IDS(); ln_pass(PRE, karg_in(16), karg_in(17), dout, XB0, gw, ngw, lane); }
    GRID_BAR();
    { pg8::Gemm g{XB0, (const bf16*)(ws + WS_W_PG), M, D, D, 0}; pg8::StaticOrder S; S.init(M, D, G, bx);
      pg8::EpiPle E{dout, dout, (const bf16*)(ws + WS_PP), XB1, karg_in(35), D};
      pg8::gemm_phase<pg8::EpiPle, pg8::StaticOrder, PG8_ALIGN, PG8_SP2>(lds + RING_OFF, g, S, E); }
    GRID_BAR();
    { pg8::Gemm g{XB1, (const bf16*)(ws + WS_W_QKV), M, 3 * D, D, 0}; pg8::StaticOrder S; S.init(M, 3 * D, G, bx);
      pg8::EpiBf16<0> E{(bf16*)(ws + WS_QKV), D, nullptr, D, (size_t)M * D, attn_body::C2};
      pg8::gemm_phase<pg8::EpiBf16<0>, pg8::StaticOrder, PG8_ALIGN, PG8_SP2>(lds + RING_OFF, g, S, E); }
    { pg8::Gemm g{(const bf16*)(ws + WS_PB) + (size_t)M * PLE, (const bf16*)(ws + WS_W_PP) + (size_t)D * PLE, M, D, PLE, 0}; pg8::StaticOrder S; S.init(M, D, G, bx);
      pg8::EpiBf16<0> E{(bf16*)(ws + WS_PP), D, nullptr, 0, 0, 1.f};
      pg8::gemm_phase<pg8::EpiBf16<0>, pg8::StaticOrder, PG8_ALIGN, PG8_SP2>(lds + RING_OFF, g, S, E); }
    GRID_BAR();
    { const attn_body::AttnTensors AT{(const attn_body::bf16*)(ws + WS_QKV), (const attn_body::bf16*)(ws + WS_QKV) + (size_t)M * D, (const attn_body::bf16*)(ws + WS_QKV) + (size_t)2 * M * D, (attn_body::bf16*)(ws + WS_OP)};
      const attn_body::StaticOrder S(G, bx);
      attn_body::attn_phase<attn_body::StaticOrder>((char*)lds_raw + RING_OFF, AT, S); }
    GRID_BAR();
    { PHASE_IDS(); attn_combine_pass(args, gw, ngw, lane); }
    GRID_BAR();
    { pg8::Gemm g{XB0, (const bf16*)(ws + WS_W_OOUT), M, D, D, 0}; pg8::StaticOrder S; S.init(M, D, G, bx);
      pg8::EpiRes E{dout, PRE, D, DN_ALPHA};
      pg8::gemm_phase<pg8::EpiRes, pg8::StaticOrder, PG8_ALIGN, PG8_SP2>(lds + RING_OFF, g, S, E); }
    GRID_BAR();
    { PHASE_IDS(); ln_router_pass(args, lds, PRE, dout, XB1, gw, ngw, lane, tid); }
    GRID_BAR();
    const int nblk = moe_setup(args, MISC, threadIdx.x);
    for (int b0 = 0; b0 < nblk; b0 += MOE_CB) { const int b1 = (b0 + MOE_CB < nblk) ? b0 + MOE_CB : nblk;
        { PHASE_IDS(); moe_gather(args, MISC, b0, b1, gw, ngw, lane); }
        GRID_BAR();
        { pg8::Gemm g{(const bf16*)(ws + WS_XIN) - (size_t)b0 * 256 * D, (const bf16*)(ws + WS_W_XGU), M, ED2, D, (size_t)ED2 * D}; MoeOrder S; S.init(b1 - b0, ED2 / 256, G, bx, b0, MISC);
          pg8::EpiGU E{(bf16*)(ws + WS_H) - (size_t)b0 * 256 * ED, ED};
          pg8::gemm_phase<pg8::EpiGU, MoeOrder, PG8_ALIGN, PG8_SP2>(lds + RING_OFF, g, S, E); }
        GRID_BAR();
        { pg8::Gemm g{(const bf16*)(ws + WS_H) - (size_t)b0 * 256 * ED, (const bf16*)(ws + WS_W_XD), M, D, ED, (size_t)D * ED}; MoeOrder S; S.init(b1 - b0, D / 256, G, bx, b0, MISC);
          pg8::EpiBf16<0> E{(bf16*)(ws + WS_Y), D, nullptr, 0, 0, 1.f};
          pg8::gemm_phase<pg8::EpiBf16<0>, MoeOrder, PG8_ALIGN, PG8_SP2>(lds + RING_OFF, g, S, E); }
        GRID_BAR();
    }
    { PHASE_IDS(); moe_combine_pass(args, MISC, dout, XB0, gw, ngw, lane); }
    GRID_BAR();
    { pg8::Gemm g{XB0, (const bf16*)(ws + WS_W_PG) + (size_t)D * D, M, D, D, 0}; pg8::StaticOrder S; S.init(M, D, G, bx);
      pg8::EpiPle E{dout, dout, (const bf16*)(ws + WS_PP), nullptr, karg_in(35) + D, D};
      pg8::gemm_phase<pg8::EpiPle, pg8::StaticOrder, PG8_ALIGN, PG8_SP2>(lds + RING_OFF, g, S, E); }
}

extern "C" void kernel_launch(void* const* d_in, const int* in_sizes, int n_in, void* d_out, int out_size, void* d_ws, size_t ws_size, hipStream_t stream) {
    static int grid = 0;
    if (grid == 0) {
        if (n_in != 36 || in_sizes[0] != M * D || out_size != M * D || ws_size < WS_END) { fprintf(stderr, "kernel_launch: unexpected shapes (n_in %d, in0 %d, out %d, ws %zu < %zu)\n", n_in, n_in > 0 ? in_sizes[0] : -1, out_size, ws_size, (size_t)WS_END); grid = -1; return; }
        int dev = 0, cus = 0, per_cu = 0;
        if (hipGetDevice(&dev) != hipSuccess || hipDeviceGetAttribute(&cus, hipDeviceAttributeMultiprocessorCount, dev) != hipSuccess) { grid = -1; return; }
        if (hipFuncSetAttribute((const void*)mega_fwd, hipFuncAttributeMaxDynamicSharedMemorySize, LDS_BYTES) != hipSuccess) { fprintf(stderr, "kernel_launch: hipFuncSetAttribute failed\n"); grid = -1; return; }
        if (hipOccupancyMaxActiveBlocksPerMultiprocessor(&per_cu, (const void*)mega_fwd, NWAVES * 64, LDS_BYTES) != hipSuccess || per_cu < 1) { fprintf(stderr, "kernel_launch: occupancy query says %d blocks per CU\n", per_cu); }
        (void)hipGetLastError();
        grid = cus;
        if (grid != 256) fprintf(stderr, "kernel_launch: %d CUs (expected 256)\n", grid);
    }
    if (grid < 0) return;
    (void)hipMemsetAsync((char*)d_ws + WS_CTL, 0, CTL_ZERO_BYTES, stream);
    KArgs a{};
    for (int i = 0; i < 36; ++i) a.in[i] = (const float*)d_in[i];
    a.out = (float*)d_out; a.ws = (unsigned char*)d_ws;
    hipLaunchKernelGGL(mega_fwd, dim3(grid), dim3(NWAVES * 64), LDS_BYTES, stream, a);
}
```

```cpp
#include <hip/hip_runtime.h>
#include <hip/hip_bf16.h>
#include <cstdio>
#include <cstdint>
#include <cmath>
namespace pg8 {
#define PG8_LAS __attribute__((address_space(3)))
typedef unsigned short bf16_t;
typedef short bf16x8 __attribute__((ext_vector_type(8)));
typedef float f32x4 __attribute__((ext_vector_type(4)));
typedef unsigned u32x4 __attribute__((ext_vector_type(4)));
constexpr int BM = 256, BK = 64, HALF = 128, HTB = HALF * BK * 2  , STAGE_BYTES = 8 * HTB, NXCD = 8, WGM = 8;

__host__ __device__ __forceinline__ int lds_byte(int r, int c) { const int st = (r >> 4) * 2 + (c >> 5), rr = r & 15, cc = c & 31, ob = rr * 64 + cc * 2; return st * 1024 + (ob ^ (((ob >> 9) & 1) << 5)); }
__host__ __device__ __forceinline__ void stage_rc(int b, int& R, int& C) { const int st = b / 1024, sb = b % 1024, swz = sb ^ (((sb >> 9) & 1) << 5); R = (st >> 1) * 16 + swz / 64; C = (st & 1) * 32 + (swz % 64) / 2; }
__host__ __device__ __forceinline__ int perm32(int rho) { const int n = rho >> 4, i = rho & 15; return 8 * (i >> 2) + 4 * n + (i & 3); }

struct Unit { int pm, pn, e; };
struct Gemm { const bf16_t* A; const bf16_t* Bt; int M, N, K; size_t bstride; };

struct StaticOrder {
    int nM, nN, nwg, G, c;
    __host__ __device__ void init(int M, int N, int G_, int c_) { nM = M / BM; nN = N / BM; nwg = nM * nN; G = G_; c = c_; }
    __host__ __device__ bool next(int i, Unit& u) const {
        const long L = (long)i * G + c; if (L >= nwg) return false;
        int wgid = (int)L; { const int q = nwg / NXCD, r = nwg % NXCD, xcd = wgid % NXCD, off = wgid / NXCD; wgid = (xcd < r ? xcd * (q + 1) : r * (q + 1) + (xcd - r) * q) + off; }
        const int nig = WGM * nN, gid = wgid / nig, fm = gid * WGM, gsz = (nM - fm) < WGM ? (nM - fm) : WGM;
        u.pm = fm + ((wgid % nig) % gsz); u.pn = (wgid % nig) / gsz; u.e = 0; return true;
    }
    __device__ __forceinline__ void a_ready(const Unit&) const {}
    __device__ __forceinline__ void done(const Unit&) const {}
};

__device__ __forceinline__ unsigned cvt_pk_bf16(float lo, float hi) { unsigned r; asm volatile("v_cvt_pk_bf16_f32 %0, %1, %2" : "=v"(r) : "v"(lo), "v"(hi)); return r; }
typedef float f32x2 __attribute__((ext_vector_type(2)));
__device__ __forceinline__ f32x2 gelu_pk(f32x2 v) {
    const f32x2 av = __builtin_elementwise_abs(v), d = av * 0.2316418882f + 1.0f;
    f32x2 t; t.x = __builtin_amdgcn_rcpf(d.x); t.y = __builtin_amdgcn_rcpf(d.y);
    f32x2 q = t * 0.5307027145f + (-0.7265760135f); q = q * t + 0.7107068705f; q = q * t + (-0.142248368f); q = q * t + 0.127414796f; q = q * t;
    const f32x2 s = (v * v) * (-0.72134752044f);
    f32x2 e; e.x = __builtin_amdgcn_exp2f(s.x); e.y = __builtin_amdgcn_exp2f(s.y);
    const f32x2 m = v * (q * e), r = v - m;
    f32x2 o; o.x = v.x < 0.f ? m.x : r.x; o.y = v.y < 0.f ? m.y : r.y; return o;
}

template <int ACT  > struct EpiBf16 {
    static constexpr bool PERM = true, AFTER_DRAIN = false; static_assert(ACT == 0 || ACT == 1, "EpiBf16: ACT is 0 (none) or 1 (gelu_pk)");
    bf16_t* O; int ldc; const float* bias; int split_cols; size_t split_stride; float scale0;
    __device__ __forceinline__ void operator()(const f32x4 (&acc)[2][2][4][2], const Unit& u, int wr, int wc, int fr, int fq) const {
        const int row0 = u.pm * BM + wr * 64 + fr; int colt = u.pn * BM; bf16_t* base = O;
        float sc = 1.f; if (split_cols) { const int t = colt / split_cols; base += (size_t)t * split_stride; colt -= t * split_cols; if (t == 0) sc = scale0; }
        const int col0 = colt + wc * 32 + 8 * fq, bcol0 = u.pn * BM + wc * 32 + 8 * fq;
        f32x4 bv[2][2];
#pragma unroll
        for (int bj = 0; bj < 2; ++bj)
#pragma unroll
            for (int n = 0; n < 2; ++n) bv[bj][n] = bias ? *(const f32x4*)(bias + bcol0 + bj * HALF + 4 * n) : (f32x4){0.f, 0.f, 0.f, 0.f};
#pragma unroll
        for (int ai = 0; ai < 2; ++ai)
#pragma unroll
            for (int m = 0; m < 4; ++m) { bf16_t* rowp = base + (size_t)(row0 + ai * HALF + m * 16) * ldc + col0;
#pragma unroll
                for (int bj = 0; bj < 2; ++bj) { f32x4 v0 = acc[ai][bj][m][0] + bv[bj][0], v1 = acc[ai][bj][m][1] + bv[bj][1];
                    if (ACT == 1) { f32x2 a = gelu_pk((f32x2){v0[0], v0[1]}), b = gelu_pk((f32x2){v0[2], v0[3]}), c = gelu_pk((f32x2){v1[0], v1[1]}), d = gelu_pk((f32x2){v1[2], v1[3]});
                        v0 = (f32x4){a.x, a.y, b.x, b.y}; v1 = (f32x4){c.x, c.y, d.x, d.y}; }
                    v0 = v0 * sc; v1 = v1 * sc; u32x4 w; w.x = cvt_pk_bf16(v0[0], v0[1]); w.y = cvt_pk_bf16(v0[2], v0[3]); w.z = cvt_pk_bf16(v1[0], v1[1]); w.w = cvt_pk_bf16(v1[2], v1[3]);
                    *(u32x4*)(rowp + bj * HALF) = w; } }
    }
};
__device__ __forceinline__ float fast_sigmoid(float x) { return __builtin_amdgcn_rcpf(1.0f + __builtin_amdgcn_exp2f(-1.4426950408889634f * x)); }
__device__ __forceinline__ float gelu_tanh(float x) { const float u = 1.5957691216057308f * (x + 0.044715f * x * x * x); return x * fast_sigmoid(u); }
__device__ __forceinline__ float silu_f(float x) { return x * fast_sigmoid(x); }
struct EpiZ {
    static constexpr bool PERM = true, AFTER_DRAIN = false;
    bf16_t* O; int ldc;
    __device__ __forceinline__ void operator()(const f32x4 (&acc)[2][2][4][2], const Unit& u, int wr, int wc, int fr, int fq) const {
        const int row0 = u.pm * BM + wr * 64 + fr, col0 = u.pn * BM + wc * 32 + 8 * fq;
        const int mode = u.pn < 4 ? 1 : (u.pn == 4 ? 2 : 0);
#pragma unroll
        for (int ai = 0; ai < 2; ++ai)
#pragma unroll
            for (int m = 0; m < 4; ++m) { bf16_t* rowp = O + (size_t)(row0 + ai * HALF + m * 16) * ldc + col0;
#pragma unroll
                for (int bj = 0; bj < 2; ++bj) { f32x4 v0 = acc[ai][bj][m][0], v1 = acc[ai][bj][m][1];
                    if (mode == 1) {
#pragma unroll
                        for (int i = 0; i < 4; ++i) { v0[i] = gelu_tanh(v0[i]); v1[i] = gelu_tanh(v1[i]); } }
                    else if (mode == 2) { v0 = v0 * 0.125f; v1 = v1 * 0.125f; }
                    u32x4 w; w.x = cvt_pk_bf16(v0[0], v0[1]); w.y = cvt_pk_bf16(v0[2], v0[3]); w.z = cvt_pk_bf16(v1[0], v1[1]); w.w = cvt_pk_bf16(v1[2], v1[3]);
                    *(u32x4*)(rowp + bj * HALF) = w; } }
    }
};
struct EpiGU {
    static constexpr bool PERM = true, AFTER_DRAIN = false;
    bf16_t* O; int ldc;
    __device__ __forceinline__ void operator()(const f32x4 (&acc)[2][2][4][2], const Unit& u, int wr, int wc, int fr, int fq) const {
        const int row0 = u.pm * BM + wr * 64 + fr, col0 = u.pn * HALF + wc * 32 + 8 * fq;
#pragma unroll
        for (int ai = 0; ai < 2; ++ai)
#pragma unroll
            for (int m = 0; m < 4; ++m) { bf16_t* rowp = O + (size_t)(row0 + ai * HALF + m * 16) * ldc + col0;
                f32x4 h0, h1;
#pragma unroll
                for (int i = 0; i < 4; ++i) { h0[i] = silu_f(acc[ai][0][m][0][i]) * acc[ai][1][m][0][i]; h1[i] = silu_f(acc[ai][0][m][1][i]) * acc[ai][1][m][1][i]; }
                u32x4 w; w.x = cvt_pk_bf16(h0[0], h0[1]); w.y = cvt_pk_bf16(h0[2], h0[3]); w.z = cvt_pk_bf16(h1[0], h1[1]); w.w = cvt_pk_bf16(h1[2], h1[3]);
                *(u32x4*)rowp = w; }
    }
};
struct EpiRes {
    static constexpr bool PERM = false, AFTER_DRAIN = false;
    const float* res; float* out; int ldc; float alpha;
    __device__ __forceinline__ void operator()(const f32x4 (&acc)[2][2][4][2], const Unit& u, int wr, int wc, int fr, int fq) const {
        const int col0 = u.pn * BM + wc * 32 + 4 * fq;
#pragma unroll
        for (int ai = 0; ai < 2; ++ai)
#pragma unroll
            for (int m = 0; m < 4; ++m) { const size_t off = (size_t)(u.pm * BM + ai * HALF + wr * 64 + m * 16 + fr) * ldc + col0;
#pragma unroll
                for (int bj = 0; bj < 2; ++bj)
#pragma unroll
                    for (int n = 0; n < 2; ++n) { const f32x4 r = *(const f32x4*)(res + off + bj * HALF + n * 16); *(f32x4*)(out + off + bj * HALF + n * 16) = r * alpha + acc[ai][bj][m][n]; } }
    }
};
struct EpiPle {
    static constexpr bool PERM = false, AFTER_DRAIN = false;
    const float* x; float* out; const bf16_t* pp; bf16_t* xb; const float* bias; int ldc;
    __device__ __forceinline__ void operator()(const f32x4 (&acc)[2][2][4][2], const Unit& u, int wr, int wc, int fr, int fq) const {
        typedef unsigned u32x2v __attribute__((ext_vector_type(2)));
        const int col0 = u.pn * BM + wc * 32 + 4 * fq;
        f32x4 bv[2][2];
#pragma unroll
        for (int bj = 0; bj < 2; ++bj)
#pragma unroll
            for (int n = 0; n < 2; ++n) bv[bj][n] = *(const f32x4*)(bias + col0 + bj * HALF + n * 16);
#pragma unroll
        for (int ai = 0; ai < 2; ++ai)
#pragma unroll
            for (int m = 0; m < 4; ++m) { const size_t off = (size_t)(u.pm * BM + ai * HALF + wr * 64 + m * 16 + fr) * ldc + col0;
#pragma unroll
                for (int bj = 0; bj < 2; ++bj)
#pragma unroll
                    for (int n = 0; n < 2; ++n) { const size_t o2 = off + bj * HALF + n * 16;
                        const f32x4 xv = *(const f32x4*)(x + o2); const u32x2v pw = *(const u32x2v*)(pp + o2); const f32x4 a = acc[ai][bj][m][n] + bv[bj][n];
                        f32x4 pv; pv[0] = __uint_as_float(pw.x << 16); pv[1] = __uint_as_float(pw.x & 0xffff0000u); pv[2] = __uint_as_float(pw.y << 16); pv[3] = __uint_as_float(pw.y & 0xffff0000u);
                        f32x4 o;
#pragma unroll
                        for (int i = 0; i < 4; ++i) o[i] = xv[i] + fast_sigmoid(a[i]) * pv[i];
                        *(f32x4*)(out + o2) = o;
                        if (xb) { u32x2v w; w.x = cvt_pk_bf16(o[0], o[1]); w.y = cvt_pk_bf16(o[2], o[3]); *(u32x2v*)(xb + o2) = w; } } }
    }
};
template <class Epi, class Sched, bool ALIGN_EPI = false, bool SP2 = false>
__device__ __forceinline__ void gemm_phase(PG8_LAS unsigned char* lds, const Gemm g, const Sched& S, const Epi& E) {
    int tid_ = threadIdx.x; asm volatile("" : "+v"(tid_));
    const int tid = tid_, wid = __builtin_amdgcn_readfirstlane(tid >> 6), lane = tid & 63, wr = wid >> 2, wc = wid & 3, fr = lane & 15, fq = lane >> 4;
    const int K = g.K, nt = K / BK;
    unsigned voffA[2], voffB[2];
#pragma unroll
    for (int i = 0; i < 2; ++i) { int R, C; stage_rc(tid * 16 + i * 8192, R, C); const int Rb = Epi::PERM ? ((R & ~31) + perm32(R & 31)) : R;
        voffA[i] = (unsigned)(R * K + C) * 2u; voffB[i] = (unsigned)(Rb * K + C) * 2u; }
    const size_t kstep = (size_t)(BK * 2);
    const size_t hstep = (size_t)HALF * K * 2;
    const size_t tstep = 2 * hstep;
    const unsigned ldsw = (unsigned)wid * 1024u;
    const int aoff = lds_byte(wr * 64 + fr, fq * 8), boff = lds_byte(wc * 32 + fr, fq * 8);
#define PG8_SA(b, h) (((b) * 2 + (h)) * HTB)
#define PG8_SB(b, h) ((4 + (b) * 2 + (h)) * HTB)
#define PG8_STAGE(bufoff, gbase, voff) do { _Pragma("unroll") for (int _i = 0; _i < 2; ++_i) \
        __builtin_amdgcn_global_load_lds((const unsigned*)((const char*)(gbase) + (voff)[_i]), (PG8_LAS unsigned*)(lds + (bufoff) + ldsw + _i * 8192), 16, 0, 0); } while (0)
#define PG8_LDA(dst, b, h) do { _Pragma("unroll") for (int m = 0; m < 4; ++m) _Pragma("unroll") for (int k = 0; k < 2; ++k) dst[m][k] = *(const PG8_LAS bf16x8*)(lds + PG8_SA(b, h) + aoff + m * 2048 + k * 1024); } while (0)
#define PG8_LDB(dst, b, h) do { _Pragma("unroll") for (int n = 0; n < 2; ++n) _Pragma("unroll") for (int k = 0; k < 2; ++k) dst[n][k] = *(const PG8_LAS bf16x8*)(lds + PG8_SB(b, h) + boff + n * 2048 + k * 1024); } while (0)
#define PG8_MMA(ai, bj, At, Bt) do { __builtin_amdgcn_s_setprio(1); _Pragma("unroll") for (int m = 0; m < 4; ++m) _Pragma("unroll") for (int n = 0; n < 2; ++n) _Pragma("unroll") for (int k = 0; k < 2; ++k) \
        acc[ai][bj][m][n] = __builtin_amdgcn_mfma_f32_16x16x32_bf16(Bt[n][k], At[m][k], acc[ai][bj][m][n], 0, 0, 0); __builtin_amdgcn_s_setprio(0); } while (0)
#define PG8_WAIT_V(n) asm volatile("s_waitcnt vmcnt(" #n ")" ::: "memory")
#define PG8_WAIT_L(n) asm volatile("s_waitcnt lgkmcnt(" #n ")" ::: "memory")
#define PG8_BAR __builtin_amdgcn_s_barrier()
#define PG8_SCHED __builtin_amdgcn_sched_barrier(0)
    Unit cur, nxt; int ui = 0;
    if (!S.next(0, cur)) return;
    f32x4 acc[2][2][4][2];
#pragma unroll
    for (int a = 0; a < 2; ++a)
#pragma unroll
        for (int b = 0; b < 2; ++b)
#pragma unroll
            for (int m = 0; m < 4; ++m)
#pragma unroll
                for (int n = 0; n < 2; ++n) acc[a][b][m][n] = (f32x4){0.f, 0.f, 0.f, 0.f};
    bf16x8 At[4][2], B0[2][2], B1[2][2];
    const char* cA = (const char*)g.A + (size_t)cur.pm * tstep; const char* cB = (const char*)g.Bt + (size_t)cur.e * g.bstride * 2 + (size_t)cur.pn * tstep;
    S.a_ready(cur);
    if constexpr (SP2) {
        PG8_STAGE(PG8_SB(0, 0), cB, voffB); PG8_STAGE(PG8_SB(0, 1), cB + hstep, voffB); PG8_STAGE(PG8_SA(0, 0), cA, voffA); PG8_STAGE(PG8_SA(0, 1), cA + hstep, voffA);
        if (wr == 1) PG8_BAR;
        PG8_WAIT_V(2); PG8_BAR;
        PG8_STAGE(PG8_SB(1, 0), cB + kstep, voffB); PG8_STAGE(PG8_SA(1, 0), cA + kstep, voffA); PG8_STAGE(PG8_SB(1, 1), cB + hstep + kstep, voffB);
        PG8_WAIT_V(6); PG8_BAR;
    } else {
        PG8_STAGE(PG8_SB(0, 0), cB, voffB); PG8_STAGE(PG8_SA(0, 0), cA, voffA); PG8_STAGE(PG8_SB(0, 1), cB + hstep, voffB); PG8_STAGE(PG8_SA(0, 1), cA + hstep, voffA);
        if (wr == 1) PG8_BAR;
        PG8_WAIT_V(4); PG8_BAR;
        PG8_STAGE(PG8_SB(1, 0), cB + kstep, voffB); PG8_STAGE(PG8_SA(1, 0), cA + kstep, voffA); PG8_STAGE(PG8_SB(1, 1), cB + hstep + kstep, voffB);
        PG8_WAIT_V(6); PG8_BAR;
    }
    for (;;) {
        const bool has_next = S.next(ui + 1, nxt);
        const char* nA = has_next ? (const char*)g.A + (size_t)nxt.pm * tstep : cA; const char* nB = has_next ? (const char*)g.Bt + (size_t)nxt.e * g.bstride * 2 + (size_t)nxt.pn * tstep : cB;
        for (int t = 0; t < nt; t += 2) {
            const bool last = (t == nt - 2);
            const char* a1 = cA + (size_t)(t + 1) * kstep;
            const char* a2 = last ? nA : cA + (size_t)(t + 2) * kstep; const char* b2 = last ? nB : cB + (size_t)(t + 2) * kstep;
            const char* a3 = a2 + kstep; const char* b3 = b2 + kstep;
            if (last && has_next) S.a_ready(nxt);
            if constexpr (SP2) {
            PG8_LDB(B0, 0, 0); PG8_LDB(B1, 0, 1); PG8_SCHED; PG8_LDA(At, 0, 0); PG8_STAGE(PG8_SA(1, 1), a1 + hstep, voffA);
            PG8_WAIT_V(8); PG8_WAIT_L(0); PG8_BAR; PG8_MMA(0, 0, At, B0); PG8_MMA(0, 1, At, B1); PG8_BAR; PG8_SCHED;
            PG8_LDA(At, 0, 1); PG8_STAGE(PG8_SB(0, 0), b2, voffB); PG8_STAGE(PG8_SB(0, 1), b2 + hstep, voffB); PG8_STAGE(PG8_SA(0, 0), a2, voffA);
            PG8_WAIT_V(8); PG8_WAIT_L(0); PG8_BAR; PG8_MMA(1, 0, At, B0); PG8_MMA(1, 1, At, B1); PG8_BAR; PG8_SCHED;
            PG8_LDB(B0, 1, 0); PG8_LDB(B1, 1, 1); PG8_SCHED; PG8_LDA(At, 1, 0); PG8_STAGE(PG8_SA(0, 1), a2 + hstep, voffA);
            PG8_WAIT_V(8); PG8_WAIT_L(0); PG8_BAR; PG8_MMA(0, 0, At, B0); PG8_MMA(0, 1, At, B1); PG8_BAR; PG8_SCHED;
            PG8_LDA(At, 1, 1); PG8_STAGE(PG8_SB(1, 0), b3, voffB); PG8_STAGE(PG8_SB(1, 1), b3 + hstep, voffB); PG8_STAGE(PG8_SA(1, 0), a3, voffA);
            PG8_WAIT_V(8); PG8_WAIT_L(0); PG8_BAR; PG8_MMA(1, 0, At, B0); PG8_MMA(1, 1, At, B1); PG8_BAR; PG8_SCHED;
            } else {
            PG8_LDB(B0, 0, 0); PG8_SCHED; PG8_LDA(At, 0, 0); PG8_STAGE(PG8_SA(1, 1), a1 + hstep, voffA);
            PG8_WAIT_L(8); PG8_BAR; PG8_WAIT_L(0); PG8_MMA(0, 0, At, B0); PG8_BAR; PG8_SCHED;
            PG8_LDB(B1, 0, 1); PG8_STAGE(PG8_SB(0, 0), b2, voffB);
            PG8_BAR; PG8_WAIT_L(0); PG8_MMA(0, 1, At, B1); PG8_BAR;
            PG8_LDA(At, 0, 1); PG8_STAGE(PG8_SA(0, 0), a2, voffA);
            PG8_BAR; PG8_WAIT_L(0); PG8_MMA(1, 0, At, B0); PG8_BAR; PG8_SCHED;
            PG8_STAGE(PG8_SB(0, 1), b2 + hstep, voffB);
            PG8_WAIT_V(6); PG8_BAR; PG8_MMA(1, 1, At, B1); PG8_BAR;
            PG8_LDB(B0, 1, 0); PG8_SCHED; PG8_LDA(At, 1, 0); PG8_STAGE(PG8_SA(0, 1), a2 + hstep, voffA);
            PG8_WAIT_L(8); PG8_BAR; PG8_WAIT_L(0); PG8_MMA(0, 0, At, B0); PG8_BAR; PG8_SCHED;
            PG8_LDB(B1, 1, 1); PG8_STAGE(PG8_SB(1, 0), b3, voffB);
            PG8_BAR; PG8_WAIT_L(0); PG8_MMA(0, 1, At, B1); PG8_BAR;
            PG8_LDA(At, 1, 1); PG8_STAGE(PG8_SA(1, 0), a3, voffA);
            PG8_BAR; PG8_WAIT_L(0); PG8_MMA(1, 0, At, B0); PG8_BAR; PG8_SCHED;
            PG8_STAGE(PG8_SB(1, 1), b3 + hstep, voffB);
            PG8_WAIT_V(6); PG8_BAR; PG8_MMA(1, 1, At, B1); PG8_BAR;
            }
        }
        if constexpr (ALIGN_EPI) { if (wr == 0) PG8_BAR; }
        if constexpr (!Epi::AFTER_DRAIN) { E(acc, cur, wr, wc, fr, fq); S.done(cur); }
        if (!has_next) break;
#pragma unroll
        for (int a = 0; a < 2; ++a)
#pragma unroll
            for (int b = 0; b < 2; ++b)
#pragma unroll
                for (int m = 0; m < 4; ++m)
#pragma unroll
                    for (int n = 0; n < 2; ++n) acc[a][b][m][n] = (f32x4){0.f, 0.f, 0.f, 0.f};
        cur = nxt; cA = nA; cB = nB; ++ui;
        if constexpr (ALIGN_EPI) { if (wr == 1) PG8_BAR; }
    }
    PG8_WAIT_V(0);
    if constexpr (!ALIGN_EPI) { if (wr == 0) PG8_BAR; }
    PG8_BAR;
    if constexpr (Epi::AFTER_DRAIN) { E.fused(acc, cur, wr, wc, fr, fq, lds, wid, lane); S.done(cur); }
#undef PG8_SA
#undef PG8_SB
#undef PG8_STAGE
#undef PG8_LDA
#undef PG8_LDB
#undef PG8_MMA
#undef PG8_WAIT_V
#undef PG8_WAIT_L
#undef PG8_BAR
#undef PG8_SCHED
}
}

#ifndef PG8_SP2
#define PG8_SP2 true
#endif
#ifndef PG8_ALIGN
#define PG8_ALIGN true
#endif
#include <hip/hip_bf16.h>
#include <cmath>
namespace attn_body {
using bf16=__hip_bfloat16;
using bf16x8=__attribute__((ext_vector_type(8)))short;
using s16x4=__attribute__((ext_vector_type(4)))short;
using f32x16=__attribute__((ext_vector_type(16)))float;
using u32x4=__attribute__((ext_vector_type(4)))unsigned;
constexpr int BATCH=4,NHEAD=16,SEQ=4096,D=64,DM=NHEAD*D,DMO=2048;
constexpr int NW=8,QBLK=32,QB=QBLK*NW,KVBLK=64,NQB=SEQ/QB;
constexpr int ATTN_PITCH=DM, ATTN_UNIT_ROWS=QB;
__device__ __forceinline__ int crow(int r,int hi){return (r&3)+8*(r>>2)+4*hi;}
#define SBAR() __builtin_amdgcn_sched_barrier(0)
__device__ __forceinline__ void cmask(f32x16&p0,f32x16&p1,int jb,int qrel,int hi){
  const float NEG=-INFINITY; int kb=64*jb+4*hi;
  #pragma unroll
  for(int r=0;r<16;++r){int kv=kb+(r&3)+8*(r>>2); if(kv>qrel)p0[r]=NEG; if(kv+32>qrel)p1[r]=NEG;}
}

constexpr int NSLOT=3, SLOTB=8192;
constexpr int LDS_K=0, LDS_V=NSLOT*SLOTB, LDS_WS=2*NSLOT*SLOTB, LDS_OST=LDS_WS+NW*64*4, LDS_BYTES=LDS_OST+NW*4096;
constexpr float C2=0.125f*1.4426950408889634f;
__device__ __forceinline__ void glds16(const void*gsrc,unsigned lds_dst){unsigned keep;
  asm volatile("s_mov_b32 %0, m0\n\ts_mov_b32 m0, %2\n\ts_nop 0\n\tglobal_load_lds_dwordx4 %1, off\n\ts_mov_b32 m0, %0":"=&s"(keep):"v"(gsrc),"s"(lds_dst):"memory");}
__device__ __forceinline__ float max3f(float a,float b,float c){float r;asm("v_max3_f32 %0, %1, %2, %3":"=v"(r):"v"(a),"v"(b),"v"(c));return r;}
__device__ __forceinline__ float max2f(float a,float b){float r;asm("v_max_f32_e32 %0, %1, %2":"=v"(r):"v"(a),"v"(b));return r;}
__device__ __forceinline__ float fadd_s(float a,float b){float r;asm("v_add_f32_e32 %0, %1, %2":"=v"(r):"v"(a),"v"(b));return r;}
__device__ __forceinline__ float fsub_s(float a,float b){float r;asm("v_sub_f32_e32 %0, %1, %2":"=v"(r):"v"(a),"v"(b));return r;}
typedef float f32x2_t __attribute__((ext_vector_type(2))); typedef __bf16 bf16x2_t __attribute__((ext_vector_type(2)));
__device__ __forceinline__ unsigned cvtpk_s(float lo,float hi){f32x2_t v={lo,hi};bf16x2_t b=__builtin_convertvector(v,bf16x2_t);return __builtin_bit_cast(unsigned,b);}
#define WAIT_BAR(N) asm volatile("s_waitcnt vmcnt(" #N ") lgkmcnt(0)\n\ts_barrier":::"memory")

__device__ __forceinline__ void qkt(f32x16&p0,f32x16&p1,const char*Kslot,const bf16x8*qr,const f32x16&negm,int r32,int hi){
  const char*kb=Kslot+hi*1024+r32*16;
  #pragma unroll
  for(int d0=0;d0<4;++d0){
    const bf16x8 b0=*reinterpret_cast<const bf16x8*>(kb+d0*2048);
    const bf16x8 b1=*reinterpret_cast<const bf16x8*>(kb+d0*2048+512);
    if(d0==0){p0=__builtin_amdgcn_mfma_f32_32x32x16_bf16(b0,qr[0],negm,0,0,0);p1=__builtin_amdgcn_mfma_f32_32x32x16_bf16(b1,qr[0],negm,0,0,0);}
    else{p0=__builtin_amdgcn_mfma_f32_32x32x16_bf16(b0,qr[d0],p0,0,0,0);p1=__builtin_amdgcn_mfma_f32_32x32x16_bf16(b1,qr[d0],p1,0,0,0);}}
}
typedef __attribute__((address_space(3))) const char* lds_cptr;
typedef short v4i16_t __attribute__((ext_vector_type(4)));
__device__ __forceinline__ void kload8(bf16x8*kf,lds_cptr kp){
  kf[0]=*(const __attribute__((address_space(3))) bf16x8*)(kp);      kf[1]=*(const __attribute__((address_space(3))) bf16x8*)(kp+512);
  kf[2]=*(const __attribute__((address_space(3))) bf16x8*)(kp+2048); kf[3]=*(const __attribute__((address_space(3))) bf16x8*)(kp+2560);
  kf[4]=*(const __attribute__((address_space(3))) bf16x8*)(kp+4096); kf[5]=*(const __attribute__((address_space(3))) bf16x8*)(kp+4608);
  kf[6]=*(const __attribute__((address_space(3))) bf16x8*)(kp+6144); kf[7]=*(const __attribute__((address_space(3))) bf16x8*)(kp+6656);
}
__device__ __forceinline__ void kload2(bf16x8*kf,lds_cptr kp,int j){ kf[2*j]=*(const __attribute__((address_space(3))) bf16x8*)(kp+j*2048); kf[2*j+1]=*(const __attribute__((address_space(3))) bf16x8*)(kp+j*2048+512); }
__device__ __forceinline__ s16x4 vtr(lds_cptr p){ return __builtin_bit_cast(s16x4,__builtin_amdgcn_ds_read_tr16_b64_v4i16((__attribute__((address_space(3))) v4i16_t*)p)); }
__device__ __forceinline__ float rowmax(const f32x16&p0,const f32x16&p1){
  float a=max3f(p0[0],p0[1],p1[0]),b=max3f(p0[2],p0[3],p1[1]);a=max3f(a,p1[2],p1[3]);
  #pragma unroll
  for(int r=4;r<16;r+=4){a=max3f(a,p0[r],p0[r+1]);b=max3f(b,p0[r+2],p0[r+3]);a=max3f(a,p1[r],p1[r+1]);b=max3f(b,p1[r+2],p1[r+3]);}
  const float m=max2f(a,b);
  auto rr=__builtin_amdgcn_permlane32_swap(__float_as_uint(m),__float_as_uint(m),false,false);
  return max2f(__uint_as_float(rr[0]),__uint_as_float(rr[1]));
}
__device__ __forceinline__ void pv(f32x16*o,int vb,bf16x8 pa0,bf16x8 pa1,bf16x8 pa2,bf16x8 pa3){
  #pragma unroll
  for(int d0=0;d0<2;++d0){s16x4 lo[4],hi[4];
    #pragma unroll
    for(int ks=0;ks<4;++ks){
      asm volatile("ds_read_b64_tr_b16 %0,%1 offset:%c2":"=&v"(lo[ks]):"v"(vb),"i"(d0*4096+ks*1024):"memory");
      asm volatile("ds_read_b64_tr_b16 %0,%1 offset:%c2":"=&v"(hi[ks]):"v"(vb),"i"(d0*4096+ks*1024+512):"memory");}
    asm volatile("s_waitcnt lgkmcnt(0)":::"memory");SBAR();
    #define PK(k) (bf16x8){lo[k][0],lo[k][1],lo[k][2],lo[k][3],hi[k][0],hi[k][1],hi[k][2],hi[k][3]}
    o[d0]=__builtin_amdgcn_mfma_f32_32x32x16_bf16(pa0,PK(0),o[d0],0,0,0);
    o[d0]=__builtin_amdgcn_mfma_f32_32x32x16_bf16(pa1,PK(1),o[d0],0,0,0);
    o[d0]=__builtin_amdgcn_mfma_f32_32x32x16_bf16(pa2,PK(2),o[d0],0,0,0);
    o[d0]=__builtin_amdgcn_mfma_f32_32x32x16_bf16(pa3,PK(3),o[d0],0,0,0);
    #undef PK
  }
}

#ifndef ATTN_STORE16
#define ATTN_STORE16(p,v) (*(u32x4*)(p)=(v))
#endif
template<int THRL> __device__ __forceinline__ void attn_unit(int b,int hq,int hv,int ho,int qb,const bf16*Q,const bf16*__restrict__ K,const bf16*__restrict__ V,bf16*O,char*shm){
  int tid_=threadIdx.x; asm volatile("":"+v"(tid_)); const int tid=tid_,lane=tid&63,r32=lane&31,hi=lane>>5; const int wid=__builtin_amdgcn_readfirstlane(tid>>6);
  const long rowbase=(long)b*SEQ; const int q0=qb*QB;
  const bf16*Qw=Q+(rowbase+q0+wid*QBLK)*DM+hq*D;
  const bf16*Kh=K+rowbase*DM+hq*D,*Vh=V+rowbase*DM+hv*D;
  const unsigned lds0=(unsigned)(uintptr_t)shm;
  float*wsf=(float*)(shm+LDS_WS)+wid*64;
  const bf16*ksrc=Kh+(long)lane*DM+wid*8;
  const bf16*vsrc=Vh+(long)(16*(wid&3)+(lane>>2))*DM+(wid>>2)*32+(lane&3)*8;
  const unsigned kdst=lds0+LDS_K+wid*1024, vdst=lds0+LDS_V+wid*1024;
  #define DMA_K(t,slot) glds16(ksrc+(long)(t)*KVBLK*DM,(unsigned)__builtin_amdgcn_readfirstlane(kdst+(slot)))
  #define DMA_V(t,slot) glds16(vsrc+(long)(t)*KVBLK*DM,(unsigned)__builtin_amdgcn_readfirstlane(vdst+(slot)))
  const int vb0=(int)(lds0+LDS_V)+((lane>>4)&1)*32+(lane&3)*8+(4*hi+((lane&15)>>2))*64;
  const char*Kbase=shm+LDS_K; bf16x8 kf[8];
  const lds_cptr shm3=(lds_cptr)shm; const lds_cptr kp0=shm3+LDS_K+hi*1024+r32*16; const lds_cptr vp0=shm3+LDS_V+((lane>>4)&1)*32+(lane&3)*8+(4*hi+((lane&15)>>2))*64;
  const int NT=(q0+QB)/KVBLK;
  DMA_K(0,0);DMA_V(0,0);DMA_K(1,SLOTB);
  bf16x8 qr[4];
  #pragma unroll
  for(int d0=0;d0<4;++d0)qr[d0]=*reinterpret_cast<const bf16x8*>(&Qw[(long)r32*DM+d0*16+hi*8]);
  float mhat=0.f,l_reg=0.f;f32x16 o[2];o[0]=f32x16{};o[1]=f32x16{};f32x16 negm=f32x16{};asm volatile("":"+v"(negm));
  const int qrel=wid*QBLK+r32;
  #define CMASK(P0,P1,t) do{int jb_=(t)-(NT-4); if(jb_>=0)cmask(P0,P1,jb_,qrel,hi);}while(0)
  bool resc=false;
  #define START(P0,P1) do{ const float rm=rowmax(P0,P1); resc=false; \
    { const float dl=rm; mhat=fadd_s(mhat,dl); \
      _Pragma("unroll") for(int r=0;r<16;++r){P0[r]=fsub_s(P0[r],dl);P1[r]=fsub_s(P1[r],dl);} \
      _Pragma("unroll") for(int r=0;r<16;++r)negm[r]=-mhat; asm volatile("":"+v"(negm)); } \
    _Pragma("unroll") for(int r=0;r<16;++r)P0[r]=__builtin_amdgcn_exp2f(P0[r]); }while(0)
  #define RESC() do{ if(resc){ asm volatile("s_waitcnt lgkmcnt(0)":::"memory"); \
      _Pragma("unroll") for(int d_=0;d_<2;++d_) _Pragma("unroll") for(int r=0;r<16;++r)o[d_][r]*=wsf[crow(r,hi)]; } }while(0)
  f32x16 pA0,pA1,pB0,pB1;
  int sl_prev=0,sl_cur=0,sl_next=SLOTB;
  #define ROT() do{sl_prev=sl_cur;sl_cur=sl_next;sl_next=(sl_next==(NSLOT-1)*SLOTB)?0:sl_next+SLOTB;}while(0)
  DMA_K(2,2*SLOTB);
  WAIT_BAR(3);
  qkt(pA0,pA1,Kbase,qr,negm,r32,hi);asm volatile("s_nop 15\n\ts_nop 7":"+v"(pA0),"+v"(pA1));CMASK(pA0,pA1,0);
  START(pA0,pA1);
  _Pragma("unroll") for(int r=0;r<16;++r)pA1[r]=__builtin_amdgcn_exp2f(pA1[r]);
  WAIT_BAR(0);
  DMA_K(3,0);DMA_V(1,SLOTB);
  ROT();
  kload8(kf,kp0+sl_cur);
  WAIT_BAR(2);
  s16x4 vlo[8],vhi[8]; u32x4 pw0,pw1,pw2,pw3;
  #define PKW(P,B) cvtpk_s(P[B],P[B+1])
  #define PAF(k) __builtin_bit_cast(bf16x8,pw##k)
  #define VFR(i) (bf16x8){vlo[i][0],vlo[i][1],vlo[i][2],vlo[i][3],vhi[i][0],vhi[i][1],vhi[i][2],vhi[i][3]}
  #define PIN(x) asm volatile("":"+v"(x))
  #define MX3(a,b,c) __builtin_fmaxf(__builtin_fmaxf((a),(b)),(c))
  #define GAPA(MF,A0,A1,A2,A3,W0,W1,PW) do{ MF; sacc+=A0; sacc+=A1; sacc+=A2; sacc+=A3; PIN(sacc); W0; W1; PIN(PW); SBAR(); }while(0)
  #define EX(v) __builtin_amdgcn_exp2f(v)
  #define GAPB(MF,X,B) do{ MF; X[B]=EX(X[B]); X[B+1]=EX(X[B+1]); X[B+2]=EX(X[B+2]); X[B+3]=EX(X[B+3]); PIN(X); SBAR(); }while(0)
  #define VRD(i) do{ vlo[i]=vtr(vp_+(((i)>>2)*4096+((i)&3)*1024)); vhi[i]=vtr(vp_+(((i)>>2)*4096+((i)&3)*1024+512)); }while(0)
  #define KRD(G,j) do{ if(G){ kload2(kf,kp0+sl_next,j); SBAR(); } }while(0)
  #define STEP(C0,C1,P0,P1,t,GK,GV,GL) do{ SBAR(); \
    const lds_cptr vp_=vp0+sl_prev; \
    VRD(0); SBAR(); float sacc=(P0[0]+P0[1]); \
    GAPA(C0=__builtin_amdgcn_mfma_f32_32x32x16_bf16(kf[0],qr[0],negm,0,0,0), P0[2],P0[3],P0[4],P0[5],     pw0[0]=PKW(P0,0), pw0[1]=PKW(P0,2), pw0); \
    VRD(4); SBAR(); GAPA(C1=__builtin_amdgcn_mfma_f32_32x32x16_bf16(kf[1],qr[0],negm,0,0,0), P0[6],P0[7],P0[8],P0[9],     pw0[2]=PKW(P0,4), pw0[3]=PKW(P0,6), pw0); \
    VRD(1); SBAR(); GAPA(C0=__builtin_amdgcn_mfma_f32_32x32x16_bf16(kf[2],qr[1],C0,0,0,0),   P0[10],P0[11],P0[12],P0[13], pw1[0]=PKW(P0,8), pw1[1]=PKW(P0,10), pw1); \
    VRD(5); SBAR(); GAPA(C1=__builtin_amdgcn_mfma_f32_32x32x16_bf16(kf[3],qr[1],C1,0,0,0),   P0[14],P0[15],P1[0],P1[1],   pw1[2]=PKW(P0,12),pw1[3]=PKW(P0,14), pw1); \
    VRD(2); SBAR(); GAPA(C0=__builtin_amdgcn_mfma_f32_32x32x16_bf16(kf[4],qr[2],C0,0,0,0),   P1[2],P1[3],P1[4],P1[5],     pw2[0]=PKW(P1,0), pw2[1]=PKW(P1,2), pw2); \
    VRD(6); SBAR(); GAPA(C1=__builtin_amdgcn_mfma_f32_32x32x16_bf16(kf[5],qr[2],C1,0,0,0),   P1[6],P1[7],P1[8],P1[9],     pw2[2]=PKW(P1,4), pw2[3]=PKW(P1,6), pw2); \
    VRD(3); SBAR(); GAPA(C0=__builtin_amdgcn_mfma_f32_32x32x16_bf16(kf[6],qr[3],C0,0,0,0),   P1[10],P1[11],P1[12],P1[13], pw3[0]=PKW(P1,8), pw3[1]=PKW(P1,10), pw3); \
    VRD(7); SBAR(); GAPA(C1=__builtin_amdgcn_mfma_f32_32x32x16_bf16(kf[7],qr[3],C1,0,0,0),   P1[14],P1[15],0.f,0.f,       pw3[2]=PKW(P1,12),pw3[3]=PKW(P1,14), pw3); \
    l_reg+=sacc; \
    if(GK){DMA_K((t)+3,sl_cur);} if(GV){DMA_V((t)+1,sl_next);} \
    CMASK(C0,C1,t); \
    { float a=MX3(C0[0],C0[1],C1[0]),b=MX3(C0[2],C0[3],C1[1]); a=MX3(a,C1[2],C1[3]); \
      _Pragma("unroll") for(int r=4;r<16;r+=4){a=MX3(a,C0[r],C0[r+1]);b=MX3(b,C0[r+2],C0[r+3]);a=MX3(a,C1[r],C1[r+1]);b=MX3(b,C1[r+2],C1[r+3]);} \
      float rm=__builtin_fmaxf(a,b); { auto rr=__builtin_amdgcn_permlane32_swap(__float_as_uint(rm),__float_as_uint(rm),false,false); rm=__builtin_fmaxf(__uint_as_float(rr[0]),__uint_as_float(rr[1])); } \
      resc=false; \
      if(__builtin_expect(__any(rm>(float)THRL),0)){ const float dl=__builtin_fmaxf(rm,0.f); mhat+=dl; \
        _Pragma("unroll") for(int r=0;r<16;++r){C0[r]-=dl;C1[r]-=dl;} \
        _Pragma("unroll") for(int r=0;r<16;++r)negm[r]=-mhat; asm volatile("":"+v"(negm)); \
        const float f=__builtin_amdgcn_exp2f(-dl); l_reg*=f; if(hi==0)wsf[r32]=f; resc=true; } } \
    SBAR(); \
    GAPB(o[0]=__builtin_amdgcn_mfma_f32_32x32x16_bf16(PAF(0),VFR(0),o[0],0,0,0), C0,0); \
    GAPB(o[1]=__builtin_amdgcn_mfma_f32_32x32x16_bf16(PAF(0),VFR(4),o[1],0,0,0), C0,4); \
    KRD(GL,0); GAPB(o[0]=__builtin_amdgcn_mfma_f32_32x32x16_bf16(PAF(1),VFR(1),o[0],0,0,0), C0,8); \
    KRD(GL,1); GAPB(o[1]=__builtin_amdgcn_mfma_f32_32x32x16_bf16(PAF(1),VFR(5),o[1],0,0,0), C0,12); \
    KRD(GL,2); GAPB(o[0]=__builtin_amdgcn_mfma_f32_32x32x16_bf16(PAF(2),VFR(2),o[0],0,0,0), C1,0); \
    KRD(GL,3); GAPB(o[1]=__builtin_amdgcn_mfma_f32_32x32x16_bf16(PAF(2),VFR(6),o[1],0,0,0), C1,4); \
    GAPB(o[0]=__builtin_amdgcn_mfma_f32_32x32x16_bf16(PAF(3),VFR(3),o[0],0,0,0), C1,8); \
    GAPB(o[1]=__builtin_amdgcn_mfma_f32_32x32x16_bf16(PAF(3),VFR(7),o[1],0,0,0), C1,12); \
    }while(0)
  int t=1;
  #undef CMASK
  #define CMASK(P0,P1,t) do{}while(0)
  for(;t+5<NT;t+=2){
    STEP(pB0,pB1,pA0,pA1,t,true,true,true);     WAIT_BAR(2); RESC(); ROT();
    STEP(pA0,pA1,pB0,pB1,t+1,true,true,true);   WAIT_BAR(2); RESC(); ROT();
  }
  #undef CMASK
  #define CMASK(P0,P1,t) do{int jb_=(t)-(NT-4); if(jb_>=0)cmask(P0,P1,jb_,qrel,hi);}while(0)
  #define ENDW(tt) do{ if((tt)+3<NT){WAIT_BAR(2);} else if((tt)+2<NT){WAIT_BAR(1);} else {WAIT_BAR(0);} }while(0)
  for(;t+1<NT;t+=2){
    STEP(pB0,pB1,pA0,pA1,t,(t+3<NT),(t+1<NT),(t+1<NT));       ENDW(t);   RESC(); ROT();
    STEP(pA0,pA1,pB0,pB1,t+1,(t+4<NT),(t+2<NT),(t+2<NT));     ENDW(t+1); RESC(); ROT();
  }
  STEP(pB0,pB1,pA0,pA1,NT-1,false,false,false); RESC();
  { float sacc=pB0[0]+pB0[1]; _Pragma("unroll") for(int r=2;r<16;++r)sacc+=pB0[r]; _Pragma("unroll") for(int r=0;r<16;++r)sacc+=pB1[r]; l_reg+=sacc;
    pw0=(u32x4){PKW(pB0,0),PKW(pB0,2),PKW(pB0,4),PKW(pB0,6)};pw1=(u32x4){PKW(pB0,8),PKW(pB0,10),PKW(pB0,12),PKW(pB0,14)};pw2=(u32x4){PKW(pB1,0),PKW(pB1,2),PKW(pB1,4),PKW(pB1,6)};pw3=(u32x4){PKW(pB1,8),PKW(pB1,10),PKW(pB1,12),PKW(pB1,14)};
    SBAR(); pv(o,vb0+sl_cur,PAF(0),PAF(1),PAF(2),PAF(3)); }
  #undef PKW
  #undef PAF
  #undef VFR
  #undef PIN
  #undef MX3
  #undef GAPA
  #undef GAPB
  #undef EX
  #undef VRD
  #undef KRD
  #undef STEP
  #undef ENDW
  {auto rr=__builtin_amdgcn_permlane32_swap(__float_as_uint(l_reg),__float_as_uint(l_reg),false,false);l_reg=__uint_as_float(rr[0])+__uint_as_float(rr[1]);}
  if(hi==0)wsf[32+r32]=l_reg;asm volatile("s_waitcnt lgkmcnt(0)":::"memory");
  float rli[16];
  #pragma unroll
  for(int r=0;r<16;++r)rli[r]=__builtin_amdgcn_rcpf(wsf[32+crow(r,hi)]);
  bf16*Ow=O+(rowbase+q0+wid*QBLK)*DMO+ho*D;
  { bf16*stg=(bf16*)(shm+LDS_OST)+wid*2048;
    #pragma unroll
    for(int r=0;r<16;++r){const int orow=crow(r,hi);
      #pragma unroll
      for(int d0=0;d0<2;++d0)stg[orow*64+d0*32+r32]=__float2bfloat16(o[d0][r]*rli[r]);}
    asm volatile("s_waitcnt lgkmcnt(0)":::"memory");
    #pragma unroll
    for(int i=0;i<4;++i){const int row=i*8+(lane>>3),ch=lane&7; const u32x4 v=*(const u32x4*)(stg+row*64+ch*8); ATTN_STORE16(Ow+(long)row*DMO+ch*8,v);} }
  asm volatile("s_waitcnt lgkmcnt(0)\n\ts_barrier":::"memory");
  #undef DMA_K
  #undef DMA_V
  #undef CMASK
  #undef START
  #undef RESC
  #undef ROT
}
constexpr int ATTN_LDS_BYTES=LDS_BYTES;
struct AttnTensors { const bf16* Q; const bf16* K; const bf16* V; bf16* O; };
struct AttnUnit { int b, hq, hv, ho, qb; };
struct StaticOrder {
  int vcu;
  __device__ __forceinline__ explicit StaticOrder(int grid,int block):vcu((block%8)*(grid/8)+block/8){}
  __device__ __forceinline__ bool next(int i,AttnUnit&u)const{ if(i>=8)return false; const int st=vcu>>1, s=4*(vcu&1)+(i>>1); const int h=(st>>2)&7, c=(st>>1)&1, vh=st&1; u.b=st>>5; u.hq=2*h+c; u.hv=2*h+vh; u.ho=(2*h+c)*2+vh; u.qb=(i&1)?15-s:s; return true; }
  __device__ __forceinline__ void a_ready(const AttnUnit&)const{}
  __device__ __forceinline__ void done(const AttnUnit&)const{}
};
template<class Sched,int THRL=8> __device__ __forceinline__ void attn_phase(char*lds,const AttnTensors&T,const Sched&S){
  AttnUnit u;
  for(int i=0;S.next(i,u);++i){ S.a_ready(u); attn_unit<THRL>(u.b,u.hq,u.hv,u.ho,u.qb,T.Q,T.K,T.V,T.O,lds); S.done(u); }
}
#undef SBAR
#undef WAIT_BAR
}
#define GAS __attribute__((address_space(1)))
#define LAS __attribute__((address_space(3)))
typedef unsigned short bf16;
typedef unsigned v4u __attribute__((ext_vector_type(4)));
typedef float f32x4 __attribute__((ext_vector_type(4)));
typedef short bf16x8 __attribute__((ext_vector_type(8)));
typedef GAS unsigned gu32;
typedef GAS unsigned long long gu64;
#define RLX_AGENT __ATOMIC_RELAXED, __HIP_MEMORY_SCOPE_AGENT
#define LDS_WAIT() asm volatile("s_waitcnt lgkmcnt(0)" ::: "memory")
#define VM_WAIT() asm volatile("s_waitcnt vmcnt(0)" ::: "memory")
__device__ __forceinline__ unsigned long long rt() { return __builtin_amdgcn_s_memrealtime(); }
__device__ __forceinline__ unsigned f2bf(float f) { unsigned u = __builtin_bit_cast(unsigned, f); return (u + 0x7fffu + ((u >> 16) & 1u)) >> 16; }
__device__ __forceinline__ unsigned pk2(float lo, float hi) { return f2bf(lo) | (f2bf(hi) << 16); }

#define XB_TMO      128
#define XB_XCNT(j)  (256  + 64 * (j))
#define XB_XSUB(j)  (1280 + 64 * (j))
#define XB_XGEN(j)  (2304 + 64 * (j))
#define XB_TOP      3328
#define XB_TOPGEN   3392
#define XCD_BAR_WORDS 3456
#define XB_SPIN_CAP (1u << 18)

__device__ __forceinline__ unsigned xb_ld(unsigned* p)              { return __hip_atomic_load(p, __ATOMIC_RELAXED, __HIP_MEMORY_SCOPE_AGENT); }
__device__ __forceinline__ unsigned xb_add(unsigned* p, unsigned v) { return __hip_atomic_fetch_add(p, v, __ATOMIC_RELAXED, __HIP_MEMORY_SCOPE_AGENT); }
__device__ __forceinline__ unsigned xb_xcc_id() { return (unsigned)__builtin_amdgcn_s_getreg((3 << 11) | 20) & 0xFu; }
#define XB_SPIN(cond, bar) do { unsigned _sp = 0; while (cond) { __builtin_amdgcn_s_sleep(1); \
    if ((++_sp & 255u) == 0u) { if (xb_ld(&(bar)[XB_TMO])) break; if (_sp > XB_SPIN_CAP) { atomicAdd(&(bar)[XB_TMO], 1u); break; } } } } while (0)

struct XcdBarrier {
    unsigned* bar; unsigned x;
    volatile LAS unsigned* st;
};

__device__ __forceinline__ XcdBarrier xcd_barrier_post(unsigned* bar, volatile LAS unsigned* st) {
    XcdBarrier b; b.bar = bar; b.x = xb_xcc_id(); b.st = st;
    if (threadIdx.x == 0) (void)xb_add(&bar[XB_XCNT(b.x)], 1u);
    return b;
}
__device__ __forceinline__ void xcd_barrier_complete(unsigned* bar, unsigned x, unsigned& nloc, unsigned& nx) {
    const unsigned G = gridDim.x * gridDim.y * gridDim.z;
    unsigned sum, cnt, mine, sp = 0u;
    for (;;) {
        sum = 0u; cnt = 0u; mine = 0u;
#pragma unroll
        for (unsigned j = 0; j < 16; ++j) { const unsigned c = xb_ld(&bar[XB_XCNT(j)]); sum += c; cnt += (c > 0u) ? 1u : 0u; mine = (j == x) ? c : mine; }
        if (sum == G) break;
        __builtin_amdgcn_s_sleep(1);
        if ((++sp & 255u) == 0u) { if (xb_ld(&bar[XB_TMO])) break; if (sp > XB_SPIN_CAP) { atomicAdd(&bar[XB_TMO], 1u); break; } }
    }
    nloc = mine > 0u ? mine : 1u; nx = cnt > 0u ? cnt : 1u;
}

__device__ __forceinline__ void xcd_barrier(const XcdBarrier& b) {
    asm volatile("s_waitcnt vmcnt(0)" ::: "memory");
    __syncthreads();
    if (threadIdx.x == 0) {
        unsigned* bar = b.bar;
        __builtin_amdgcn_s_waitcnt(0);
        unsigned nloc = b.st[0], nx = b.st[1];
        if (nloc == 0u) { xcd_barrier_complete(bar, b.x, nloc, nx); b.st[0] = nloc; b.st[1] = nx; }
        const unsigned old = xb_add(&bar[XB_XSUB(b.x)], 1u);
        const unsigned gen = old / nloc;
        if (old + 1u == (gen + 1u) * nloc) {
            __builtin_amdgcn_fence(__ATOMIC_RELEASE, "agent");
            asm volatile("s_waitcnt vmcnt(0)" ::: "memory");
            const unsigned og = xb_add(&bar[XB_TOP], 1u);
            const unsigned tg = og / nx;
            if (og + 1u == (tg + 1u) * nx) xb_add(&bar[XB_TOPGEN], 1u);
            else XB_SPIN(xb_ld(&bar[XB_TOPGEN]) == tg, bar);
            __builtin_amdgcn_fence(__ATOMIC_ACQUIRE, "agent");
            xb_add(&bar[XB_XGEN(b.x)], 1u);
            asm volatile("s_waitcnt vmcnt(0)" ::: "memory");
        } else {
            XB_SPIN(xb_ld(&bar[XB_XGEN(b.x)]) == gen, bar);
            __builtin_amdgcn_fence(__ATOMIC_ACQUIRE, "agent");
            asm volatile("s_waitcnt vmcnt(0)" ::: "memory");
        }
    }
    __syncthreads();
}

#define REP_P0 1
#define REP_P1 1
#define REP_GLA 1
#define REP_P5 1
#define REP_P6 1
#define REP_P7 1
#define REP_P8 1
#define REP_P11 1
#define REP_P12 1
#define REP_P13 1
#define REP_P14 1
#define REP_MOE 1
constexpr int NWAVES = 8;
constexpr int BATCH = 4, SEQ = 4096, D = 1024, M = BATCH * SEQ;
constexpr int ZC = 2576, ZN = 2816;
constexpr int FF = 2816, FF2 = 2 * FF;
constexpr int NE = 8, ED = 3584, ED2 = 2 * ED;
constexpr int PLE = 256;
constexpr int MOE_CB = 46;
constexpr int MOE_MAXB = 136;
constexpr float LN_EPS = 1e-5f;
constexpr float DN_ALPHA = 1.4142135623730951f;
constexpr float LAMBDA_INIT = 0.35550906759096926f;
constexpr int ZU = 0, ZV = 512, ZQ = 1024, ZK = 1280, ZVB = 1536, ZR = 2048, ZG = 2560;

constexpr size_t MiB = 1u << 20;
constexpr size_t WS_CTL = 0, CTL_ZERO_BYTES = 1 * MiB;
constexpr size_t WS_LISTS = 1 * MiB;
constexpr size_t WS_TOKINFO = 1 * MiB + 512 * 1024;
constexpr size_t WS_DECAY = 2 * MiB;
constexpr size_t WS_W_IN = 4 * MiB, WS_W_EOUT = WS_W_IN + (size_t)ZN * D * 2, WS_W_FGU = WS_W_EOUT + 2 * MiB, WS_W_FD = WS_W_FGU + (size_t)FF2 * D * 2,
                 WS_W_QKV = WS_W_FD + (size_t)D * FF * 2, WS_W_OOUT = WS_W_QKV + 6 * MiB, WS_W_PG = WS_W_OOUT + 2 * MiB, WS_W_PP = WS_W_PG + 4 * MiB,
                 WS_W_XGU = WS_W_PP + 1 * MiB, WS_W_XD = WS_W_XGU + (size_t)NE * ED2 * D * 2, WS_W_END = WS_W_XD + (size_t)NE * D * ED * 2;
static_assert(WS_W_END == 209 * MiB, "weight map");
constexpr size_t WS_XB0 = 209 * MiB, WS_XB1 = 241 * MiB, WS_PB = 273 * MiB, WS_PP = 289 * MiB, WS_S = 321 * MiB;
constexpr size_t WS_ZB = WS_S, WS_MIX = WS_S + 88 * MiB, WS_KVC = WS_S + 120 * MiB, WS_SPREV = WS_S + 152 * MiB;
constexpr size_t WS_PRE = WS_S;
constexpr size_t WS_HB = WS_S + 64 * MiB;
constexpr size_t WS_QKV = WS_S, WS_OP = WS_S + 96 * MiB;
constexpr size_t WS_XIN = WS_S, WS_H = WS_S + 23 * MiB, WS_Y = WS_S + 104 * MiB;
constexpr size_t WS_END = 500 * MiB;
static_assert(WS_Y + (size_t)MOE_MAXB * 256 * D * 2 <= WS_END && WS_H + (size_t)MOE_CB * 256 * ED * 2 <= WS_Y && WS_SPREV + 16 * MiB <= WS_END && WS_OP + 64 * MiB <= WS_END && WS_HB + (size_t)M * FF * 2 <= WS_END, "scratch map");
constexpr int CW_BAR = 4096;
constexpr int CW_CNT = 1024;

constexpr int RING_OFF = 0, RING_BYTES = 131072;
constexpr int LDSCTL_OFF = 146432, MISC_OFF = LDSCTL_OFF + 320;
constexpr int LDS_BYTES = 147456;

typedef GAS f32x4 gf32x4;
__device__ __forceinline__ float bf2f(unsigned short h) { return __uint_as_float((unsigned)h << 16); }
__device__ __forceinline__ float wave_sum(float v) {
#pragma unroll
    for (int o = 1; o < 64; o <<= 1) v += __shfl_xor(v, o);
    return v;
}

__device__ __forceinline__ void tr_item(const float* W, int K, int N, bf16* WT, int mode, int rowadd, LAS float* scr, int item, int lane) {
    const int nblk = (N + 63) / 64, kb = item / nblk, nb = item - kb * nblk, k0 = 64 * kb, n0 = 64 * nb;
    const int c4 = (lane & 15) * 4, rsub = lane >> 4;
    const bool ok = (n0 + c4) < N;
    const float* src = W + (size_t)(k0 + rsub) * N + n0 + c4;
    f32x4 v[16];
#pragma unroll
    for (int i = 0; i < 16; ++i) v[i] = ok ? *(const gf32x4*)(src + (size_t)(4 * i) * N) : (f32x4){0.f, 0.f, 0.f, 0.f};
#pragma unroll
    for (int i = 0; i < 16; ++i) { LAS float* d = scr + (4 * i + rsub) * 65 + c4; d[0] = v[i][0]; d[1] = v[i][1]; d[2] = v[i][2]; d[3] = v[i][3]; }
    LDS_WAIT(); asm volatile("" ::: "memory");
    const int c = lane & 7;
    const int drow0 = mode ? ((n0 >> 7) * 256 + (n0 & 127) + rowadd) : (n0 + rowadd);
#pragma unroll
    for (int j = 0; j < 8; ++j) { const int n = (lane >> 3) + 8 * j; const LAS float* s = scr + (8 * c) * 65 + n;
        v4u o; o.x = pg8::cvt_pk_bf16(s[0 * 65], s[1 * 65]); o.y = pg8::cvt_pk_bf16(s[2 * 65], s[3 * 65]); o.z = pg8::cvt_pk_bf16(s[4 * 65], s[5 * 65]); o.w = pg8::cvt_pk_bf16(s[6 * 65], s[7 * 65]);
        if (n0 + n < N) *(GAS v4u*)(WT + (size_t)(drow0 + n) * K + k0 + 8 * c) = o; }
    LDS_WAIT(); asm volatile("" ::: "memory");
}

struct KArgs { const float* in[36]; float* out; unsigned char* ws; };
#define CAS __attribute__((address_space(4)))
__device__ __forceinline__ unsigned long long karg_u64(unsigned off) { asm volatile("" : "+s"(off)); return *(const CAS unsigned long long*)((const CAS char*)__builtin_amdgcn_kernarg_segment_ptr() + off); }
__device__ __forceinline__ const float* karg_in(int i) { return (const float*)karg_u64((unsigned)i * 8u); }
__device__ __forceinline__ float* karg_out() { return (float*)karg_u64(36u * 8u); }
__device__ __forceinline__ unsigned char* karg_ws() { return (unsigned char*)karg_u64(37u * 8u); }
struct KA { unsigned char* ws; };

__device__ __forceinline__ void p0_prologue(const KA& a, LAS unsigned char* lds, int vcu, int G, int wave, int lane) {
    unsigned char* ws = a.ws;
    LAS float* scr = (LAS float*)(lds + RING_OFF + wave * 16640);
    const int gw = vcu * NWAVES + wave, NGW = G * NWAVES;
    constexpr int I_IN = 16 * 41, I_SQ = 16 * 16, I_FU = 16 * 44, I_FD = 44 * 16, I_QKV = 16 * 48, I_PP = 4 * 16, I_XU = 16 * 56, I_XD = 56 * 16;
    constexpr int N_DENSE = I_IN + I_SQ + 3 * I_FU + I_QKV + I_SQ + 2 * I_SQ + 2 * I_PP;
    constexpr int NITEMS = N_DENSE + 8 * (2 * I_XU + I_XD);
    for (int it = gw; it < NITEMS; it += NGW) {
        int r = it;
        if (r >= N_DENSE) { r -= N_DENSE; const int e = r / (2 * I_XU + I_XD); r -= e * (2 * I_XU + I_XD);
            if (r < I_XU) { tr_item(karg_in(28) + (size_t)e * D * ED, D, ED, (bf16*)(ws + WS_W_XGU) + (size_t)e * ED2 * D, 1, 0, scr, r, lane); continue; } r -= I_XU;
            if (r < I_XU) { tr_item(karg_in(29) + (size_t)e * D * ED, D, ED, (bf16*)(ws + WS_W_XGU) + (size_t)e * ED2 * D, 1, 128, scr, r, lane); continue; } r -= I_XU;
            tr_item(karg_in(30) + (size_t)e * ED * D, ED, D, (bf16*)(ws + WS_W_XD) + (size_t)e * D * ED, 0, 0, scr, r, lane); continue; }
        if (r < I_IN) { tr_item(karg_in(2), D, ZC, (bf16*)(ws + WS_W_IN), 0, 0, scr, r, lane); continue; } r -= I_IN;
        if (r < I_SQ) { tr_item(karg_in(10), D, D, (bf16*)(ws + WS_W_EOUT), 0, 0, scr, r, lane); continue; } r -= I_SQ;
        if (r < I_FU) { tr_item(karg_in(13), D, FF, (bf16*)(ws + WS_W_FGU), 1, 0, scr, r, lane); continue; } r -= I_FU;
        if (r < I_FU) { tr_item(karg_in(14), D, FF, (bf16*)(ws + WS_W_FGU), 1, 128, scr, r, lane); continue; } r -= I_FU;
        if (r < I_FD) { tr_item(karg_in(15), FF, D, (bf16*)(ws + WS_W_FD), 0, 0, scr, r, lane); continue; } r -= I_FD;
        if (r < I_QKV) { tr_item(karg_in(18), D, 3 * D, (bf16*)(ws + WS_W_QKV), 0, 0, scr, r, lane); continue; } r -= I_QKV;
        if (r < I_SQ) { tr_item(karg_in(24), D, D, (bf16*)(ws + WS_W_OOUT), 0, 0, scr, r, lane); continue; } r -= I_SQ;
        if (r < I_SQ) { tr_item(karg_in(34), D, D, (bf16*)(ws + WS_W_PG), 0, 0, scr, r, lane); continue; } r -= I_SQ;
        if (r < I_SQ) { tr_item(karg_in(34) + (size_t)D * D, D, D, (bf16*)(ws + WS_W_PG) + (size_t)D * D, 0, 0, scr, r, lane); continue; } r -= I_SQ;
        if (r < I_PP) { tr_item(karg_in(33), PLE, D, (bf16*)(ws + WS_W_PP), 0, 0, scr, r, lane); continue; } r -= I_PP;
        tr_item(karg_in(33) + (size_t)PLE * D, PLE, D, (bf16*)(ws + WS_W_PP) + (size_t)D * PLE, 0, 0, scr, r, lane);
    }
    const int gt = gw * 64 + lane, NGT = NGW * 64;
    { GAS v4u* z = (GAS v4u*)(ws + WS_W_IN + (size_t)ZC * D * 2); for (int i = gt; i < (ZN - ZC) * D * 2 / 16; i += NGT) z[i] = (v4u){0u, 0u, 0u, 0u}; }
    { const gf32x4* xs = (const gf32x4*)karg_in(0); GAS v4u* xd = (GAS v4u*)(ws + WS_XB0);
      for (int i = gt; i < M * D / 8; i += NGT) { const f32x4 u0 = xs[2 * i], u1 = xs[2 * i + 1]; xd[i] = (v4u){pk2(u0[0], u0[1]), pk2(u0[2], u0[3]), pk2(u1[0], u1[1]), pk2(u1[2], u1[3])}; }
      const gf32x4* ps = (const gf32x4*)karg_in(1); GAS v4u* pd = (GAS v4u*)(ws + WS_PB);
      for (int i = gt; i < 2 * M * PLE / 8; i += NGT) { const f32x4 u0 = ps[2 * i], u1 = ps[2 * i + 1]; pd[i] = (v4u){pk2(u0[0], u0[1]), pk2(u0[2], u0[3]), pk2(u1[0], u1[1]), pk2(u1[2], u1[3])}; } }
}

__device__ __forceinline__ f32x4 mm16(const LAS bf16* A, int lda, const LAS bf16* Bt, int ldb, int K, int lane, f32x4 acc) {
    const int r = lane & 15, q = lane >> 4;
    for (int k = 0; k < K; k += 32) {
        const bf16x8 a = *(const LAS bf16x8*)(A + r * lda + k + 8 * q);
        const bf16x8 b = *(const LAS bf16x8*)(Bt + r * ldb + k + 8 * q);
        acc = __builtin_amdgcn_mfma_f32_16x16x32_bf16(a, b, acc, 0, 0, 0);
    }
    return acc;
}
#define WG_SYNC() __syncthreads()

__device__ __forceinline__ void gmlp_item(const KA& a, LAS unsigned char* lds, int chunk, int tid) {
    const int lane = tid & 63, wave = tid >> 6;
    const bf16* zb = (const bf16*)(a.ws + WS_ZB); bf16* mix = (bf16*)(a.ws + WS_MIX);
    const float* ln_g = karg_in(3); const float* ln_b = karg_in(4); const float* wsp = karg_in(5); const float* bsp = karg_in(6);
    const int t0 = chunk * 128;
    LAS float* stat = (LAS float*)(lds + 96 * 1024);
    LAS bf16* vnT = (LAS bf16*)lds;
    constexpr int LDV = 136;
    { const int row = tid >> 2, part = tid & 3; const bf16* vp = zb + (size_t)(t0 + row) * ZN + ZV + part * 128;
      float s = 0.f, s2 = 0.f;
#pragma unroll
      for (int i = 0; i < 16; ++i) { const v4u w = *(const GAS v4u*)(vp + i * 8);
#pragma unroll
          for (int j = 0; j < 4; ++j) { const float lo = __uint_as_float(w[j] << 16), hi = __uint_as_float(w[j] & 0xffff0000u); s += lo + hi; s2 += lo * lo + hi * hi; } }
      s += __shfl_xor(s, 1); s += __shfl_xor(s, 2); s2 += __shfl_xor(s2, 1); s2 += __shfl_xor(s2, 2);
      const float mean = s * (1.f / 512.f), var = s2 * (1.f / 512.f) - mean * mean;
      if (part == 0) { stat[row * 2] = mean; stat[row * 2 + 1] = 1.0f / sqrtf(fmaxf(var, 0.f) + LN_EPS); } }
    WG_SYNC();
    for (int hh = 0; hh < 2; ++hh) {
        for (int i = tid; i < 128 * 32; i += 512) { const int s = i >> 5, c8 = (i & 31) * 8; const int ch = hh * 256 + c8;
            const v4u w = *(const GAS v4u*)(zb + (size_t)(t0 + s) * ZN + ZV + ch); const float mean = stat[s * 2], rstd = stat[s * 2 + 1];
#pragma unroll
            for (int j = 0; j < 4; ++j) { const float lo = __uint_as_float(w[j] << 16), hi = __uint_as_float(w[j] & 0xffff0000u);
                vnT[(c8 + 2 * j) * LDV + s] = (bf16)f2bf((lo - mean) * rstd * ln_g[ch + 2 * j] + ln_b[ch + 2 * j]);
                vnT[(c8 + 2 * j + 1) * LDV + s] = (bf16)f2bf((hi - mean) * rstd * ln_g[ch + 2 * j + 1] + ln_b[ch + 2 * j + 1]); } }
        WG_SYNC();
        const int r = lane & 15, q = lane >> 4, trow = wave * 16 + r;
        for (int gl = 0; gl < 4; ++gl) { const int g = hh * 4 + gl;
            f32x4 acc[4];
#pragma unroll
            for (int dt = 0; dt < 4; ++dt) acc[dt] = (f32x4){0.f, 0.f, 0.f, 0.f};
            const float* wrow = wsp + ((size_t)g * 128 + trow) * 128;
            const int nks = (wave * 16 + 15) / 32 + 1;
            for (int ks = 0; ks < nks; ++ks) { const int k0 = ks * 32 + 8 * q;
                const f32x4 w0 = *(const gf32x4*)(wrow + k0), w1 = *(const gf32x4*)(wrow + k0 + 4);
                bf16x8 af;
#pragma unroll
                for (int j = 0; j < 4; ++j) { af[j] = (short)f2bf((k0 + j <= trow) ? w0[j] : 0.f); af[4 + j] = (short)f2bf((k0 + 4 + j <= trow) ? w1[j] : 0.f); }
#pragma unroll
                for (int dt = 0; dt < 4; ++dt) { const bf16x8 b = *(const LAS bf16x8*)(vnT + (gl * 64 + dt * 16 + r) * LDV + k0);
                    acc[dt] = __builtin_amdgcn_mfma_f32_16x16x32_bf16(af, b, acc[dt], 0, 0, 0); } }
#pragma unroll
            for (int i = 0; i < 4; ++i) { const int t = wave * 16 + 4 * q + i; const float bias = bsp[g * 128 + t];
#pragma unroll
                for (int dt = 0; dt < 4; ++dt) { const int col = g * 64 + dt * 16 + r; const float u = bf2f(zb[(size_t)(t0 + t) * ZN + ZU + col]);
                    mix[(size_t)(t0 + t) * D + col] = (bf16)f2bf(u * (acc[dt][i] + bias)); } } }
        WG_SYNC();
    }
}

__device__ __forceinline__ void gla_bcum(const KA& a, LAS unsigned char* lds, int t0, int h, int tid, LAS float* bc  , LAS float* tmp  ) {
    const int lane = tid & 63, wave = tid >> 6;
    const bf16* zb = (const bf16*)(a.ws + WS_ZB);
    LAS float* gl = tmp; LAS float* wg = tmp + 64 * 16;
    for (int i = tid; i < 64 * 16; i += 512) { const int l = i >> 4, j = i & 15; gl[i] = bf2f(zb[(size_t)(t0 + l) * ZN + ZG + j]); }
    const float* wgu = karg_in(7); const float* bgt = karg_in(8);
    for (int i = tid; i < 16 * 64; i += 512) { const int j = i >> 6, d = i & 63; wg[i] = wgu[j * 256 + h * 64 + d]; }
    WG_SYNC();
#pragma unroll
    for (int dd = 0; dd < 8; ++dd) { const int d = wave * 8 + dd; float s = bgt[h * 64 + d];
#pragma unroll
        for (int j = 0; j < 16; ++j) s += gl[lane * 16 + j] * wg[j * 64 + d];
        float la = (fminf(s, 0.f) - log1pf(__expf(-fabsf(s)))) * (1.0f / 16.0f);
#pragma unroll
        for (int o = 1; o < 64; o <<= 1) { const float v = __shfl_up(la, o); if (lane >= o) la += v; }
        bc[lane * 65 + d] = la; }
    WG_SYNC();
}

__device__ __forceinline__ void gla_kv_item(const KA& a, LAS unsigned char* lds, int item, int tid) {
    const int lane = tid & 63, wave = tid >> 6;
    const int h = item & 3, c = (item >> 2) & 63, b = item >> 8, t0 = b * SEQ + c * 64;
    const bf16* zb = (const bf16*)(a.ws + WS_ZB);
    LAS float* bc = (LAS float*)lds;
    LAS float* tmp = (LAS float*)(lds + 17408);
    LAS bf16* kdT = (LAS bf16*)(lds + 32768);
    LAS bf16* vT = (LAS bf16*)(lds + 32768 + 64 * 72 * 2);
    gla_bcum(a, lds, t0, h, tid, bc, tmp);
    for (int i = tid; i < 64 * 64; i += 512) { const int l = i >> 6, d = i & 63; const float kk = bf2f(zb[(size_t)(t0 + l) * ZN + ZK + h * 64 + d]);
        kdT[d * 72 + l] = (bf16)f2bf(kk * __expf(bc[63 * 65 + d] - bc[l * 65 + d])); }
    for (int i = tid; i < 64 * 128; i += 512) { const int l = i >> 7, e = i & 127; vT[e * 72 + l] = zb[(size_t)(t0 + l) * ZN + ZVB + h * 128 + e]; }
    if (tid < 64) ((float*)(a.ws + WS_DECAY))[item * 64 + tid] = __expf(bc[63 * 65 + tid]);
    WG_SYNC();
    const int dt = wave & 3, r = lane & 15, q = lane >> 4;
    float* kvc = (float*)(a.ws + WS_KVC) + (size_t)item * 64 * 128;
#pragma unroll
    for (int j = 0; j < 4; ++j) { const int et = (wave >> 2) * 4 + j;
        f32x4 acc = mm16(kdT + dt * 16 * 72, 72, vT + et * 16 * 72, 72, 64, lane, (f32x4){0.f, 0.f, 0.f, 0.f});
#pragma unroll
        for (int i = 0; i < 4; ++i) kvc[(dt * 16 + 4 * q + i) * 128 + et * 16 + r] = acc[i]; }
    WG_SYNC();
}

__device__ __forceinline__ void gla_scan(const KA& a, int gtid, int ngt) {
    const float* kvc = (const float*)(a.ws + WS_KVC); const float* dec = (const float*)(a.ws + WS_DECAY); bf16* sp = (bf16*)(a.ws + WS_SPREV);
    for (int idx = gtid; idx < BATCH * 4 * 64 * 128; idx += ngt) { const int e = idx & 127, d = (idx >> 7) & 63, h = (idx >> 13) & 3, b = idx >> 15;
        float S = 0.f;
#pragma unroll 8
        for (int c = 0; c < 64; ++c) { const int item = (b * 64 + c) * 4 + h; const size_t o = (size_t)item * 8192 + d * 128 + e;
            sp[o] = (bf16)f2bf(S); S = dec[item * 64 + d] * S + kvc[o]; } }
}

__device__ __forceinline__ void gla_out_item(const KA& a, LAS unsigned char* lds, int item, int tid) {
    const int lane = tid & 63, wave = tid >> 6;
    const int h = item & 3, c = (item >> 2) & 63, b = item >> 8, t0 = b * SEQ + c * 64;
    const bf16* zb = (const bf16*)(a.ws + WS_ZB); bf16* mix = (bf16*)(a.ws + WS_MIX);
    LAS float* bc = (LAS float*)lds;
    LAS float* tmp = (LAS float*)(lds + 17408);
    LAS bf16* qd = (LAS bf16*)(lds + 32768);
    LAS bf16* kd2 = qd + 64 * 72;
    LAS bf16* qb = kd2 + 64 * 72;
    LAS bf16* sc = qb + 64 * 72;
    LAS bf16* vT = sc + 64 * 72;
    LAS bf16* sT = vT + 128 * 72;
    gla_bcum(a, lds, t0, h, tid, bc, tmp);
    for (int i = tid; i < 64 * 64; i += 512) { const int l = i >> 6, d = i & 63; const float bl = bc[l * 65 + d], br = bc[31 * 65 + d];
        const float qq = bf2f(zb[(size_t)(t0 + l) * ZN + ZQ + h * 64 + d]), kk = bf2f(zb[(size_t)(t0 + l) * ZN + ZK + h * 64 + d]);
        qd[l * 72 + d] = (bf16)f2bf(qq * __expf(bl - br)); kd2[l * 72 + d] = (bf16)f2bf(kk * __expf(br - bl)); qb[l * 72 + d] = (bf16)f2bf(qq * __expf(bl)); }
    const bf16* sp = (const bf16*)(a.ws + WS_SPREV) + (size_t)item * 8192;
    for (int i = tid; i < 64 * 128; i += 512) { const int l = i >> 7, e = i & 127; vT[e * 72 + l] = zb[(size_t)(t0 + l) * ZN + ZVB + h * 128 + e]; sT[e * 72 + l] = sp[l * 128 + e]; }
    WG_SYNC();
    const int r = lane & 15, q = lane >> 4;
    { const int lt = wave >> 1;
#pragma unroll
      for (int j = 0; j < 2; ++j) { const int mt = (wave & 1) * 2 + j;
          f32x4 acc = mm16(qd + lt * 16 * 72, 72, kd2 + mt * 16 * 72, 72, 64, lane, (f32x4){0.f, 0.f, 0.f, 0.f});
#pragma unroll
          for (int i = 0; i < 4; ++i) { const int l = lt * 16 + 4 * q + i, m = mt * 16 + r; sc[l * 72 + m] = (bf16)f2bf(m <= l ? acc[i] : 0.f); } } }
    WG_SYNC();
    const int lt = wave >> 1; f32x4 o[4]; float ssq[4] = {0.f, 0.f, 0.f, 0.f};
#pragma unroll
    for (int j = 0; j < 4; ++j) { const int et = (wave & 1) * 4 + j;
        o[j] = mm16(sc + lt * 16 * 72, 72, vT + et * 16 * 72, 72, 64, lane, (f32x4){0.f, 0.f, 0.f, 0.f});
        o[j] = mm16(qb + lt * 16 * 72, 72, sT + et * 16 * 72, 72, 64, lane, o[j]);
#pragma unroll
        for (int i = 0; i < 4; ++i) ssq[i] += o[j][i] * o[j][i]; }
    LAS float* ss = tmp;
#pragma unroll
    for (int i = 0; i < 4; ++i) { float v = ssq[i]; v += __shfl_xor(v, 1); v += __shfl_xor(v, 2); v += __shfl_xor(v, 4); v += __shfl_xor(v, 8);
        if (r == 0) ss[(wave & 1) * 64 + lt * 16 + 4 * q + i] = v; }
    WG_SYNC();
    const float* ng = karg_in(9);
#pragma unroll
    for (int i = 0; i < 4; ++i) { const int l = lt * 16 + 4 * q + i; const float rstd = 1.0f / sqrtf((ss[l] + ss[64 + l]) * (1.f / 128.f) + LN_EPS);
#pragma unroll
        for (int j = 0; j < 4; ++j) { const int e = ((wave & 1) * 4 + j) * 16 + r; const float rr = bf2f(zb[(size_t)(t0 + l) * ZN + ZR + h * 128 + e]);
            mix[(size_t)(t0 + l) * D + 512 + h * 128 + e] = (bf16)f2bf(o[j][i] * rstd * ng[e] * pg8::silu_f(rr)); } }
    WG_SYNC();
}

__device__ __forceinline__ void ln_apply_store(f32x4 (&v)[4], const float* g, const float* bta, float* of, bf16* ob, int lane) {
    float s = 0.f;
#pragma unroll
    for (int j = 0; j < 4; ++j) s += (v[j][0] + v[j][1]) + (v[j][2] + v[j][3]);
    const float mean = wave_sum(s) * (1.f / D); float s2 = 0.f;
#pragma unroll
    for (int j = 0; j < 4; ++j) { v[j] = v[j] - mean; s2 += (v[j][0] * v[j][0] + v[j][1] * v[j][1]) + (v[j][2] * v[j][2] + v[j][3] * v[j][3]); }
    const float rstd = 1.0f / sqrtf(wave_sum(s2) * (1.f / D) + LN_EPS);
#pragma unroll
    for (int j = 0; j < 4; ++j) { const f32x4 gg = *(const gf32x4*)(g + 4 * lane + 256 * j), bb = *(const gf32x4*)(bta + 4 * lane + 256 * j);
        v[j] = v[j] * rstd * gg + bb;
        *(gf32x4*)(of + 4 * lane + 256 * j) = v[j];
        *(GAS unsigned long long*)(ob + 4 * lane + 256 * j) = (unsigned long long)pk2(v[j][0], v[j][1]) | ((unsigned long long)pk2(v[j][2], v[j][3]) << 32); }
}
__device__ __forceinline__ void ln_pass(const float* pre, const float* g, const float* bta, float* of, bf16* ob, int gw, int ngw, int lane) {
    for (int m = gw; m < M; m += ngw) { f32x4 v[4];
#pragma unroll
        for (int j = 0; j < 4; ++j) v[j] = *(const gf32x4*)(pre + (size_t)m * D + 4 * lane + 256 * j);
        ln_apply_store(v, g, bta, of + (size_t)m * D, ob + (size_t)m * D, lane); }
}
__device__ __forceinline__ void ln_router_pass(const KA& a, LAS unsigned char* lds, const float* pre, float* of, bf16* ob, int gw, int ngw, int lane, int tid) {
    LAS float* wr = (LAS float*)lds;
    for (int i = tid; i < D * NE / 4; i += 512) ((LAS f32x4*)wr)[i] = ((const gf32x4*)karg_in(27))[i];
    WG_SYNC();
    unsigned* cnt = (unsigned*)(a.ws + WS_CTL) + CW_CNT; int* lists = (int*)(a.ws + WS_LISTS); int* tinfo = (int*)(a.ws + WS_TOKINFO);
    const float* lng = karg_in(25); const float* lnb = karg_in(26);
    for (int m = gw; m < M; m += ngw) { f32x4 v[4];
#pragma unroll
        for (int j = 0; j < 4; ++j) v[j] = *(const gf32x4*)(pre + (size_t)m * D + 4 * lane + 256 * j);
        ln_apply_store(v, lng, lnb, of + (size_t)m * D, ob + (size_t)m * D, lane);
        float lg[8];
#pragma unroll
        for (int e = 0; e < 8; ++e) lg[e] = 0.f;
#pragma unroll
        for (int j = 0; j < 4; ++j)
#pragma unroll
            for (int i = 0; i < 4; ++i) { const int col = 4 * lane + 256 * j + i; const f32x4 w0 = *(const LAS f32x4*)(wr + col * 8), w1 = *(const LAS f32x4*)(wr + col * 8 + 4);
#pragma unroll
                for (int e = 0; e < 4; ++e) { lg[e] += v[j][i] * w0[e]; lg[4 + e] += v[j][i] * w1[e]; } }
#pragma unroll
        for (int e = 0; e < 8; ++e) lg[e] = wave_sum(lg[e]);
        if (lane == 0) {
            int e1 = 0; float v1 = lg[0];
#pragma unroll
            for (int e = 1; e < 8; ++e) if (lg[e] > v1) { v1 = lg[e]; e1 = e; }
            int e2 = -1; float v2 = -INFINITY;
#pragma unroll
            for (int e = 0; e < 8; ++e) if (e != e1 && lg[e] > v2) { v2 = lg[e]; e2 = e; }
            const float g2 = 1.0f / (1.0f + __expf(v1 - v2)), g1 = 1.0f - g2;
            const int p1 = (int)atomicAdd(cnt + e1, 1u), p2 = (int)atomicAdd(cnt + e2, 1u);
            lists[e1 * M + p1] = m; lists[e2 * M + p2] = m;
            int* ti = tinfo + (size_t)m * 8; ti[0] = e1; ti[1] = p1; ti[2] = e2; ti[3] = p2; ((float*)ti)[4] = g1; ((float*)ti)[5] = g2;
        }
    }
}
__device__ __forceinline__ void attn_combine_pass(const KA& a, int gw, int ngw, int lane) {
    const bf16* op = (const bf16*)(a.ws + WS_OP); bf16* ao = (bf16*)(a.ws + WS_XB0);
    const float lam = __expf(wave_sum(karg_in(19)[lane] * karg_in(20)[lane])) - __expf(wave_sum(karg_in(21)[lane] * karg_in(22)[lane])) + LAMBDA_INIT;
    const int h = lane >> 3, e0 = (lane & 7) * 16; const float* sg = karg_in(23);
    for (int m = gw; m < M; m += ngw) { const bf16* p0 = op + (size_t)m * 2048 + h * 256 + e0; const bf16* p1 = p0 + 128;
        float o[16]; float ssq = 0.f;
#pragma unroll
        for (int k = 0; k < 2; ++k) { const v4u w0 = *(const GAS v4u*)(p0 + 8 * k), w1 = *(const GAS v4u*)(p1 + 8 * k);
#pragma unroll
            for (int j = 0; j < 4; ++j) { const float a0 = __uint_as_float(w0[j] << 16), a1 = __uint_as_float(w0[j] & 0xffff0000u), b0 = __uint_as_float(w1[j] << 16), b1 = __uint_as_float(w1[j] & 0xffff0000u);
                const float x0 = a0 - lam * b0, x1 = a1 - lam * b1; o[8 * k + 2 * j] = x0; o[8 * k + 2 * j + 1] = x1; ssq += x0 * x0 + x1 * x1; } }
        ssq += __shfl_xor(ssq, 1); ssq += __shfl_xor(ssq, 2); ssq += __shfl_xor(ssq, 4);
        const float sc = (1.0f / sqrtf(ssq * (1.f / 128.f) + LN_EPS)) * (1.0f - LAMBDA_INIT);
        v4u w[2];
#pragma unroll
        for (int k = 0; k < 2; ++k)
#pragma unroll
            for (int j = 0; j < 4; ++j) w[k][j] = pk2(o[8 * k + 2 * j] * sc * sg[e0 + 8 * k + 2 * j], o[8 * k + 2 * j + 1] * sc * sg[e0 + 8 * k + 2 * j + 1]);
        GAS v4u* dst = (GAS v4u*)(ao + (size_t)m * D + h * 128 + e0); dst[0] = w[0]; dst[1] = w[1]; }
}
__device__ __forceinline__ int moe_setup(const KA& a, volatile LAS unsigned* MISC, int tid) {
    if (tid == 0) { const unsigned* cnt = (const unsigned*)(a.ws + WS_CTL) + CW_CNT; unsigned acc = 0;
        for (int e = 0; e < NE; ++e) { acc += (__hip_atomic_load(cnt + e, __ATOMIC_RELAXED, __HIP_MEMORY_SCOPE_AGENT) + 255u) >> 8; MISC[16 + e] = acc; } }
    WG_SYNC();
    return (int)MISC[16 + NE - 1];
}
__device__ __forceinline__ int moe_blk_expert(volatile LAS unsigned* MISC, int blk) { int e = 0;
#pragma unroll
    for (int i = 0; i < NE - 1; ++i) e += ((unsigned)blk >= MISC[16 + i]) ? 1 : 0;
    return e; }
__device__ __forceinline__ void moe_gather(const KA& a, volatile LAS unsigned* MISC, int b0, int b1, int gw, int ngw, int lane) {
    const unsigned* cnt = (const unsigned*)(a.ws + WS_CTL) + CW_CNT; const int* lists = (const int*)(a.ws + WS_LISTS);
    const bf16* xs = (const bf16*)(a.ws + WS_XB1); bf16* xin = (bf16*)(a.ws + WS_XIN);
    for (int rr = gw; rr < (b1 - b0) * 256; rr += ngw) { const int blk = b0 + (rr >> 8); const int e = moe_blk_expert(MISC, blk); const int pstart = e ? (int)MISC[16 + e - 1] : 0;
        const int li = (blk - pstart) * 256 + (rr & 255); const int n = (int)__hip_atomic_load(cnt + e, __ATOMIC_RELAXED, __HIP_MEMORY_SCOPE_AGENT);
        v4u w0 = (v4u){0u, 0u, 0u, 0u}, w1 = w0;
        if (li < n) { const int tok = lists[e * M + li]; const GAS v4u* s = (const GAS v4u*)(xs + (size_t)tok * D); w0 = s[lane]; w1 = s[64 + lane]; }
        GAS v4u* d = (GAS v4u*)(xin + (size_t)rr * D); d[lane] = w0; d[64 + lane] = w1; }
}
__device__ __forceinline__ void moe_combine_pass(const KA& a, volatile LAS unsigned* MISC, float* of, bf16* ob, int gw, int ngw, int lane) {
    const bf16* y = (const bf16*)(a.ws + WS_Y); const int* tinfo = (const int*)(a.ws + WS_TOKINFO);
    const float* lng = karg_in(31); const float* lnb = karg_in(32);
    for (int m = gw; m < M; m += ngw) { const int* ti = tinfo + (size_t)m * 8; const int e1 = ti[0], p1 = ti[1], e2 = ti[2], p2 = ti[3]; const float g1 = ((const float*)ti)[4], g2 = ((const float*)ti)[5];
        const size_t r1 = (size_t)(e1 ? MISC[16 + e1 - 1] : 0u) * 256 + p1, r2 = (size_t)(e2 ? MISC[16 + e2 - 1] : 0u) * 256 + p2;
        f32x4 v[4];
#pragma unroll
        for (int j = 0; j < 4; ++j) { const f32x4 xv = *(const gf32x4*)(of + (size_t)m * D + 4 * lane + 256 * j);
            const unsigned long long w1 = *(const GAS unsigned long long*)(y + r1 * D + 4 * lane + 256 * j), w2 = *(const GAS unsigned long long*)(y + r2 * D + 4 * lane + 256 * j);
            f32x4 y1, y2; y1[0] = __uint_as_float((unsigned)w1 << 16); y1[1] = __uint_as_float((unsigned)w1 & 0xffff0000u); y1[2] = __uint_as_float((unsigned)(w1 >> 32) << 16); y1[3] = __uint_as_float((unsigned)(w1 >> 32) & 0xffff0000u);
            y2[0] = __uint_as_float((unsigned)w2 << 16); y2[1] = __uint_as_float((unsigned)w2 & 0xffff0000u); y2[2] = __uint_as_float((unsigned)(w2 >> 32) << 16); y2[3] = __uint_as_float((unsigned)(w2 >> 32) & 0xffff0000u);
            v[j] = xv * DN_ALPHA + (y1 * g1 + y2 * g2); }
        ln_apply_store(v, lng, lnb, of + (size_t)m * D, ob + (size_t)m * D, lane); }
}

struct MoeOrder {
    pg8::StaticOrder so; int b0; volatile LAS unsigned* MISC;
    __device__ __forceinline__ void init(int nb, int nN, int G, int c, int b0_, volatile LAS unsigned* misc) { so.nM = nb; so.nN = nN; so.nwg = nb * nN; so.G = G; so.c = c; b0 = b0_; MISC = misc; }
    __device__ __forceinline__ bool next(int i, pg8::Unit& u) const { if (!so.next(i, u)) return false; u.pm += b0; u.e = moe_blk_expert(MISC, u.pm); return true; }
    __device__ __forceinline__ void a_ready(const pg8::Unit&) const {}
    __device__ __forceinline__ void done(const pg8::Unit&) const {}
};

__global__ void __launch_bounds__(NWAVES * 64, 2) mega_fwd(KArgs args_unused) {
    extern __shared__ __attribute__((aligned(16))) unsigned char lds_raw[];
    LAS unsigned char* lds = (LAS unsigned char*)lds_raw;
    volatile LAS unsigned* MISC = (volatile LAS unsigned*)(lds + MISC_OFF);
#define PHASE_IDS() int tid = threadIdx.x; asm volatile("" : "+v"(tid)); const int lane = tid & 63; (void)lane
    const int wave = __builtin_amdgcn_readfirstlane(threadIdx.x >> 6);
    const int G = gridDim.x, bx = blockIdx.x, vcu = (G % 8 == 0) ? (bx % 8) * (G / 8) + bx / 8 : bx;
    unsigned char* ws = karg_ws();
    KA args; args.ws = ws;
    gu32* ctl = (gu32*)(ws + WS_CTL);
    for (int u = threadIdx.x; u < (LDS_BYTES - LDSCTL_OFF) / 4; u += NWAVES * 64) ((LAS unsigned*)(lds + LDSCTL_OFF))[u] = 0u;
    __syncthreads();
    XcdBarrier bar = xcd_barrier_post((unsigned*)(ctl + CW_BAR), MISC + 8);
#define GRID_BAR() xcd_barrier(bar)
    const int gw = vcu * NWAVES + wave, ngw = G * NWAVES;
    float* dout = karg_out();
    bf16* XB0 = (bf16*)(ws + WS_XB0); bf16* XB1 = (bf16*)(ws + WS_XB1); float* PRE = (float*)(ws + WS_PRE);

    for (int rep_ = 0; rep_ < REP_P0; ++rep_) {
    { PHASE_IDS(); p0_prologue(args, lds, vcu, G, wave, lane); }
    GRID_BAR();
    }
    for (int rep_ = 0; rep_ < REP_P1; ++rep_) {
    { pg8::Gemm g{XB0, (const bf16*)(ws + WS_W_IN), M, ZN, D, 0}; pg8::StaticOrder S; S.init(M, ZN, G, bx);
      pg8::EpiZ E{(bf16*)(ws + WS_ZB), ZN};
      pg8::gemm_phase<pg8::EpiZ, pg8::StaticOrder, PG8_ALIGN, PG8_SP2>(lds + RING_OFF, g, S, E); }
    { pg8::Gemm g{(const bf16*)(ws + WS_PB), (const bf16*)(ws + WS_W_PP), M, D, PLE, 0}; pg8::StaticOrder S; S.init(M, D, G, bx);
      pg8::EpiBf16<0> E{(bf16*)(ws + WS_PP), D, nullptr, 0, 0, 1.f};
      pg8::gemm_phase<pg8::EpiBf16<0>, pg8::StaticOrder, PG8_ALIGN, PG8_SP2>(lds + RING_OFF, g, S, E); }
    GRID_BAR();
    }
    for (int rep_ = 0; rep_ < REP_GLA; ++rep_) {
    { PHASE_IDS(); for (int it = vcu; it < 128 + 1024; it += G) { if (it < 128) gmlp_item(args, lds, it, tid); else gla_kv_item(args, lds, it - 128, tid); } }
    GRID_BAR();
    { PHASE_IDS(); gla_scan(args, gw * 64 + lane, ngw * 64); }
    GRID_BAR();
    { PHASE_IDS(); for (int it = vcu; it < 1024; it += G) gla_out_item(args, lds, it, tid); }
    GRID_BAR();
    }
    for (int rep_ = 0; rep_ < REP_P5; ++rep_) {
    { pg8::Gemm g{(const bf16*)(ws + WS_MIX), (const bf16*)(ws + WS_W_EOUT), M, D, D, 0}; pg8::StaticOrder S; S.init(M, D, G, bx);
      pg8::EpiRes E{karg_in(0), PRE, D, DN_ALPHA};
      pg8::gemm_phase<pg8::EpiRes, pg8::StaticOrder, PG8_ALIGN, PG8_SP2>(lds + RING_OFF, g, S, E); }
    GRID_BAR();
    }
    for (int rep_ = 0; rep_ < REP_P6; ++rep_) {
    { PHASE_IDS(); ln_pass(PRE, karg_in(11), karg_in(12), dout, XB1, gw, ngw, lane); }
    GRID_BAR();
    }
    for (int rep_ = 0; rep_ < REP_P7; ++rep_) {
    { pg8::Gemm g{XB1, (const bf16*)(ws + WS_W_FGU), M, FF2, D, 0}; pg8::StaticOrder S; S.init(M, FF2, G, bx);
      pg8::EpiGU E{(bf16*)(ws + WS_HB), FF};
      pg8::gemm_phase<pg8::EpiGU, pg8::StaticOrder, PG8_ALIGN, PG8_SP2>(lds + RING_OFF, g, S, E); }
    GRID_BAR();
    }
    for (int rep_ = 0; rep_ < REP_P8; ++rep_) {
    { pg8::Gemm g{(const bf16*)(ws + WS_HB), (const bf16*)(ws + WS_W_FD), M, D, FF, 0}; pg8::StaticOrder S; S.init(M, D, G, bx);
      pg8::EpiRes E{dout, PRE, D, DN_ALPHA};
      pg8::gemm_phase<pg8::EpiRes, pg8::StaticOrder, PG8_ALIGN, PG8_SP2>(lds + RING_OFF, g, S, E); }
    GRID_BAR();
    }
    { PHASE_IDS(); ln_pass(PRE, karg_in(16), karg_in(17), dout, XB0, gw, ngw, lane); }
    GRID_BAR();
    { pg8::Gemm g{XB0, (const bf16*)(ws + WS_W_PG), M, D, D, 0}; pg8::StaticOrder S; S.init(M, D, G, bx);
      pg8::EpiPle E{dout, dout, (const bf16*)(ws + WS_PP), XB1, karg_in(35), D};
      pg8::gemm_phase<pg8::EpiPle, pg8::StaticOrder, PG8_ALIGN, PG8_SP2>(lds + RING_OFF, g, S, E); }
    GRID_BAR();
    for (int rep_ = 0; rep_ < REP_P11; ++rep_) {
    { pg8::Gemm g{XB1, (const bf16*)(ws + WS_W_QKV), M, 3 * D, D, 0}; pg8::StaticOrder S; S.init(M, 3 * D, G, bx);
      pg8::EpiBf16<0> E{(bf16*)(ws + WS_QKV), D, nullptr, D, (size_t)M * D, attn_body::C2};
      pg8::gemm_phase<pg8::EpiBf16<0>, pg8::StaticOrder, PG8_ALIGN, PG8_SP2>(lds + RING_OFF, g, S, E); }
    { pg8::Gemm g{(const bf16*)(ws + WS_PB) + (size_t)M * PLE, (const bf16*)(ws + WS_W_PP) + (size_t)D * PLE, M, D, PLE, 0}; pg8::StaticOrder S; S.init(M, D, G, bx);
      pg8::EpiBf16<0> E{(bf16*)(ws + WS_PP), D, nullptr, 0, 0, 1.f};
      pg8::gemm_phase<pg8::EpiBf16<0>, pg8::StaticOrder, PG8_ALIGN, PG8_SP2>(lds + RING_OFF, g, S, E); }
    GRID_BAR();
    }
    for (int rep_ = 0; rep_ < REP_P12; ++rep_) {
    { const attn_body::AttnTensors AT{(const attn_body::bf16*)(ws + WS_QKV), (const attn_body::bf16*)(ws + WS_QKV) + (size_t)M * D, (const attn_body::bf16*)(ws + WS_QKV) + (size_t)2 * M * D, (attn_body::bf16*)(ws + WS_OP)};
      const attn_body::StaticOrder S(G, bx);
      attn_body::attn_phase<attn_body::StaticOrder>((char*)lds_raw + RING_OFF, AT, S); }
    GRID_BAR();
    }
    for (int rep_ = 0; rep_ < REP_P13; ++rep_) {
    { PHASE_IDS(); attn_combine_pass(args, gw, ngw, lane); }
    GRID_BAR();
    }
    for (int rep_ = 0; rep_ < REP_P14; ++rep_) {
    { pg8::Gemm g{XB0, (const bf16*)(ws + WS_W_OOUT), M, D, D, 0}; pg8::StaticOrder S; S.init(M, D, G, bx);
      pg8::EpiRes E{dout, PRE, D, DN_ALPHA};
      pg8::gemm_phase<pg8::EpiRes, pg8::StaticOrder, PG8_ALIGN, PG8_SP2>(lds + RING_OFF, g, S, E); }
    GRID_BAR();
    }
    { PHASE_IDS(); ln_router_pass(args, lds, PRE, dout, XB1, gw, ngw, lane, tid); }
    GRID_BAR();
    const int nblk = moe_setup(args, MISC, threadIdx.x);
    for (int rep_ = 0; rep_ < REP_MOE; ++rep_)
    for (int b0 = 0; b0 < nblk; b0 += MOE_CB) { const int b1 = (b0 + MOE_CB < nblk) ? b0 + MOE_CB : nblk;
        { PHASE_IDS(); moe_gather(args, MISC, b0, b1, gw, ngw, lane); }
        GRID_BAR();
        { pg8::Gemm g{(const bf16*)(ws + WS_XIN) - (size_t)b0 * 256 * D, (const bf16*)(ws + WS_W_XGU), M, ED2, D, (size_t)ED2 * D}; MoeOrder S; S.init(b1 - b0, ED2 / 256, G, bx, b0, MISC);
          pg8::EpiGU E{(bf16*)(ws + WS_H) - (size_t)b0 * 256 * ED, ED};
          pg8::gemm_phase<pg8::EpiGU, MoeOrder, PG8_ALIGN, PG8_SP2>(lds + RING_OFF, g, S, E); }
        GRID_BAR();
        { pg8::Gemm g{(const bf16*)(ws + WS_H) - (size_t)b0 * 256 * ED, (const bf16*)(ws + WS_W_XD), M, D, ED, (size_t)D * ED}; MoeOrder S; S.init(b1 - b0, D / 256, G, bx, b0, MISC);
          pg8::EpiBf16<0> E{(bf16*)(ws + WS_Y), D, nullptr, 0, 0, 1.f};
          pg8::gemm_phase<pg8::EpiBf16<0>, MoeOrder, PG8_ALIGN, PG8_SP2>(lds + RING_OFF, g, S, E); }
        GRID_BAR();
    }
    { PHASE_IDS(); moe_combine_pass(args, MISC, dout, XB0, gw, ngw, lane); }
    GRID_BAR();
    { pg8::Gemm g{XB0, (const bf16*)(ws + WS_W_PG) + (size_t)D * D, M, D, D, 0}; pg8::StaticOrder S; S.init(M, D, G, bx);
      pg8::EpiPle E{dout, dout, (const bf16*)(ws + WS_PP), nullptr, karg_in(35) + D, D};
      pg8::gemm_phase<pg8::EpiPle, pg8::StaticOrder, PG8_ALIGN, PG8_SP2>(lds + RING_OFF, g, S, E); }
}

extern "C" void kernel_launch(void* const* d_in, const int* in_sizes, int n_in, void* d_out, int out_size, void* d_ws, size_t ws_size, hipStream_t stream) {
    static int grid = 0;
    if (grid == 0) {
        if (n_in != 36 || in_sizes[0] != M * D || out_size != M * D || ws_size < WS_END) { fprintf(stderr, "kernel_launch: unexpected shapes (n_in %d, in0 %d, out %d, ws %zu < %zu)\n", n_in, n_in > 0 ? in_sizes[0] : -1, out_size, ws_size, (size_t)WS_END); grid = -1; return; }
        int dev = 0, cus = 0, per_cu = 0;
        if (hipGetDevice(&dev) != hipSuccess || hipDeviceGetAttribute(&cus, hipDeviceAttributeMultiprocessorCount, dev) != hipSuccess) { grid = -1; return; }
        if (hipFuncSetAttribute((const void*)mega_fwd, hipFuncAttributeMaxDynamicSharedMemorySize, LDS_BYTES) != hipSuccess) { fprintf(stderr, "kernel_launch: hipFuncSetAttribute failed\n"); grid = -1; return; }
        if (hipOccupancyMaxActiveBlocksPerMultiprocessor(&per_cu, (const void*)mega_fwd, NWAVES * 64, LDS_BYTES) != hipSuccess || per_cu < 1) { fprintf(stderr, "kernel_launch: occupancy query says %d blocks per CU\n", per_cu); }
        (void)hipGetLastError();
        grid = cus;
        if (grid != 256) fprintf(stderr, "kernel_launch: %d CUs (expected 256)\n", grid);
    }
    if (grid < 0) return;
    (void)hipMemsetAsync((char*)d_ws + WS_CTL, 0, CTL_ZERO_BYTES, stream);
    KArgs a{};
    for (int i = 0; i < 36; ++i) a.in[i] = (const float*)d_in[i];
    a.out = (float*)d_out; a.ws = (unsigned char*)d_ws;
    hipLaunchKernelGGL(mega_fwd, dim3(grid), dim3(NWAVES * 64), LDS_BYTES, stream, a);
}
```
